# Optimizing an MI355X kernel written in HIP

```python
import jax
import jax.numpy as jnp
from jax import lax
import numpy as np

D_MODEL = 1024
BATCH = 8
SEQ = 4096
DEPTH = 2

HEAD_DIM = 64
ROPE_THETA = 10000.0
LN_EPS = 1e-5
DEEPNORM_ALPHA = (2 * DEPTH) ** 0.25
DEEPNORM_BETA = (8 * DEPTH) ** -0.25
N_ADA = 6
MAX_POS_OFFSET = 4096

A_HEADS = 4
MOBA_BLOCK = 256
MOBA_TOPK = 3
MOBA_Q_CHUNK = 64

B_HEADS = 6
B_KV_GROUPS = 2
B_REP = B_HEADS // B_KV_GROUPS
CMP_BLOCK = 32
CMP_STRIDE = 16
CMP_HIDDEN = 128
SLC_BLOCK = 64
SLC_TOPK = 16
NSA_WINDOW = 512
NSA_Q_CHUNK = 64
N_NSA_BRANCHES = 3
FORCE_SCORE = 1e6

DILATED_PAIRS = ((128, 1), (512, 4), (2048, 16))
C_HEADS_PER_GROUP = 2
C_HEADS = C_HEADS_PER_GROUP * len(DILATED_PAIRS)
BAND_Q = 128

N_BRANCHES = 3

N_EXPERTS = 32
TOP_K = 4
D_EXPERT = D_MODEL
SWIGLU_ALPHA = 1.702
SWIGLU_LIMIT = 7.0
EXPERT_ROW_BLOCK = 256

IN_LAYOUT = (
    ("a_q", A_HEADS * HEAD_DIM), ("a_k", A_HEADS * HEAD_DIM), ("a_v", A_HEADS * HEAD_DIM),
    ("b_q", B_HEADS * HEAD_DIM),
    ("b_kc", B_KV_GROUPS * HEAD_DIM), ("b_vc", B_KV_GROUPS * HEAD_DIM),
    ("b_ks", B_KV_GROUPS * HEAD_DIM), ("b_vs", B_KV_GROUPS * HEAD_DIM),
    ("b_kw", B_KV_GROUPS * HEAD_DIM), ("b_vw", B_KV_GROUPS * HEAD_DIM),
    ("b_gate", B_HEADS * N_NSA_BRANCHES),
    ("c_q", C_HEADS * HEAD_DIM), ("c_k", C_HEADS * HEAD_DIM), ("c_v", C_HEADS * HEAD_DIM),
    ("merge_gate", N_BRANCHES * D_MODEL),
)
IN_WIDTH = sum(w for _, w in IN_LAYOUT)
V_COLUMNS = ("a_v", "b_vc", "b_vs", "b_vw", "c_v")

kernel_name = "hybrid_moba_nsa_dilated_moe_deepnorm"


def _layer_norm(x):
    xf = x.astype(jnp.float32)
    mu = xf.mean(-1, keepdims=True)
    var = jnp.mean(jnp.square(xf - mu), -1, keepdims=True)
    return ((xf - mu) * lax.rsqrt(var + LN_EPS)).astype(x.dtype)


def _affine_ln(x, g, b):
    return _layer_norm(x) * g + b


def _rope_tables(positions):
    inv = ROPE_THETA ** (-jnp.arange(0, HEAD_DIM, 2, dtype=jnp.float32) / HEAD_DIM)
    ang = positions.astype(jnp.float32)[..., None] * inv
    return jnp.cos(ang)[:, :, None, :], jnp.sin(ang)[:, :, None, :]


def _rope(x, cos, sin):
    x1, x2 = jnp.split(x, 2, axis=-1)
    cos = cos.astype(x.dtype)
    sin = sin.astype(x.dtype)
    return jnp.concatenate([x1 * cos - x2 * sin, x2 * cos + x1 * sin], axis=-1)


def _split_in(proj):
    offs = [int(o) for o in np.cumsum([w for _, w in IN_LAYOUT])[:-1]]
    parts = jnp.split(proj, offs, axis=-1)
    return {name: p for (name, _), p in zip(IN_LAYOUT, parts)}


def _gather_blocks(blocks, idx):
    return jax.vmap(jax.vmap(lambda a, i: a[i]))(blocks, idx)


def _banded_attention(q, k, v, window):
    b, s, g, r, dh = q.shape
    span = window - 1
    pad = ((0, 0), (span, 0), (0, 0), (0, 0))
    kp = jnp.pad(k, pad)
    vp = jnp.pad(v, pad)
    nq = s // BAND_Q
    qb = q.reshape(b, nq, BAND_Q, g, r, dh).transpose(1, 0, 3, 4, 2, 5)
    rel = jnp.arange(BAND_Q)[:, None] + span - jnp.arange(BAND_Q + span)[None, :]
    band = (rel >= 0) & (rel < window)
    scale = dh ** -0.5

    def block(args):
        q_blk, ci = args
        start = ci * BAND_Q
        kw = lax.dynamic_slice_in_dim(kp, start, BAND_Q + span, axis=1)
        vw = lax.dynamic_slice_in_dim(vp, start, BAND_Q + span, axis=1)
        key_pos = start - span + jnp.arange(BAND_Q + span)
        ok = band & (key_pos >= 0)[None, :]
        sc = jnp.einsum("bgrqd,bkgd->bgrqk", q_blk, kw).astype(jnp.float32) * scale
        sc = jnp.where(ok, sc, -jnp.inf)
        m = jnp.max(sc, -1, keepdims=True)
        e = jnp.exp(sc - m)
        den = e.sum(-1, keepdims=True)
        o = jnp.einsum("bgrqk,bkgd->bgrqd", (e / den).astype(v.dtype), vw)
        return o, (m + jnp.log(den))[..., 0]

    o, lse = lax.map(block, (qb, jnp.arange(nq)))
    o = o.transpose(1, 0, 4, 2, 3, 5).reshape(b, s, g, r, dh)
    lse = lse.transpose(1, 0, 4, 2, 3).reshape(b, s, g, r)
    return o, lse


def _moba_attention(q, k, v):
    b, s, h, dh = q.shape
    nb = -(-s // MOBA_BLOCK)
    pad = ((0, 0), (0, nb * MOBA_BLOCK - s), (0, 0), (0, 0))
    kb = jnp.pad(k, pad).reshape(b, nb, MOBA_BLOCK, h, dh).transpose(0, 3, 1, 2, 4)
    vb = jnp.pad(v, pad).reshape(b, nb, MOBA_BLOCK, h, dh).transpose(0, 3, 1, 2, 4)
    k_mean = kb.astype(jnp.float32).mean(axis=3)
    n_sel = min(MOBA_TOPK, nb - 1)
    n_chunks = s // MOBA_Q_CHUNK
    qc = q.reshape(b, n_chunks, MOBA_Q_CHUNK, h, dh).transpose(1, 0, 3, 2, 4)
    scale = dh ** -0.5
    blk_ids = jnp.arange(nb)
    key_off = jnp.arange(MOBA_BLOCK)

    def chunk(args):
        q_blk, ci = args
        t = ci * MOBA_Q_CHUNK + jnp.arange(MOBA_Q_CHUNK)
        own = (ci * MOBA_Q_CHUNK) // MOBA_BLOCK
        k_own = lax.dynamic_index_in_dim(kb, own, axis=2, keepdims=False)
        v_own = lax.dynamic_index_in_dim(vb, own, axis=2, keepdims=False)
        s_own = jnp.einsum("bhqd,bhld->bhql", q_blk, k_own).astype(jnp.float32) * scale
        s_own = jnp.where((own * MOBA_BLOCK + key_off)[None, :] <= t[:, None], s_own, -jnp.inf)
        if n_sel == 0:
            p = jax.nn.softmax(s_own, axis=-1).astype(v.dtype)
            return jnp.einsum("bhql,bhld->bhqd", p, v_own)
        gate = jnp.einsum("bhqd,bhnd->bhqn", q_blk.astype(jnp.float32), k_mean)
        gate = jnp.where(blk_ids < own, gate, -jnp.inf)
        _, sel = lax.top_k(gate, n_sel)
        valid = sel < own
        k_sel = _gather_blocks(kb, sel)
        v_sel = _gather_blocks(vb, sel)
        s_sel = jnp.einsum("bhqd,bhqnld->bhqnl", q_blk, k_sel).astype(jnp.float32) * scale
        s_sel = jnp.where(valid[..., None], s_sel, -jnp.inf)
        s_sel = s_sel.reshape(b, h, MOBA_Q_CHUNK, n_sel * MOBA_BLOCK)
        p = jax.nn.softmax(jnp.concatenate([s_sel, s_own], -1), axis=-1).astype(v.dtype)
        p_sel = p[..., : n_sel * MOBA_BLOCK].reshape(b, h, MOBA_Q_CHUNK, n_sel, MOBA_BLOCK)
        p_own = p[..., n_sel * MOBA_BLOCK:]
        return (jnp.einsum("bhqnl,bhqnld->bhqd", p_sel, v_sel)
                + jnp.einsum("bhql,bhld->bhqd", p_own, v_own))

    out = lax.map(chunk, (qc, jnp.arange(n_chunks)))
    return out.transpose(1, 0, 3, 2, 4).reshape(b, s, h, dh)


def _nsa_compress(x, w1, w2, pe):
    b, s, g, dh = x.shape
    nc = (s - CMP_BLOCK) // CMP_STRIDE + 1
    idx = jnp.arange(nc)[:, None] * CMP_STRIDE + jnp.arange(CMP_BLOCK)[None, :]
    blocks = x[:, idx] + pe[None, None, :, None, :]
    flat = blocks.transpose(0, 1, 3, 2, 4).reshape(b, nc, g, CMP_BLOCK * dh)
    return jax.nn.silu(flat @ w1) @ w2


def _nsa_attention(q, k_cmp, v_cmp, k_slc, v_slc, k_win, v_win, gate_logits):
    b, s, g, r, dh = q.shape
    nc = k_cmp.shape[1]
    ns = s // SLC_BLOCK
    n_sel = min(SLC_TOPK, ns)
    scale = dh ** -0.5
    cmp_start = jnp.arange(nc) * CMP_STRIDE
    cmp_end = cmp_start + CMP_BLOCK - 1
    slc_start = jnp.arange(ns) * SLC_BLOCK
    overlap = ((cmp_start[:, None] < slc_start[None, :] + SLC_BLOCK)
               & (cmp_start[:, None] + CMP_BLOCK > slc_start[None, :])).astype(jnp.float32)
    ksb = k_slc.reshape(b, ns, SLC_BLOCK, g, dh).transpose(0, 3, 1, 2, 4)
    vsb = v_slc.reshape(b, ns, SLC_BLOCK, g, dh).transpose(0, 3, 1, 2, 4)
    nq = s // NSA_Q_CHUNK
    qc = q.reshape(b, nq, NSA_Q_CHUNK, g, r, dh).transpose(1, 0, 3, 4, 2, 5)
    blk_ids = jnp.arange(ns)
    key_off = jnp.arange(SLC_BLOCK)

    def chunk(args):
        q_blk, ci = args
        t = ci * NSA_Q_CHUNK + jnp.arange(NSA_Q_CHUNK)
        sc = jnp.einsum("bgrqd,bngd->bgrqn", q_blk, k_cmp).astype(jnp.float32) * scale
        vis = cmp_end[None, :] <= t[:, None]
        sc = jnp.where(vis, sc, -jnp.inf)
        m = jnp.max(sc, -1, keepdims=True)
        m = jnp.where(jnp.isfinite(m), m, 0.0)
        e = jnp.where(vis, jnp.exp(sc - m), 0.0)
        p_cmp = e / jnp.maximum(e.sum(-1, keepdims=True), 1e-30)
        o_cmp = jnp.einsum("bgrqn,bngd->bgrqd", p_cmp.astype(v_cmp.dtype), v_cmp)
        imp = jnp.einsum("bgrqn,nm->bgqm", p_cmp, overlap)
        q_blk_id = (t // SLC_BLOCK)[:, None]
        forced = (blk_ids[None, :] == 0) | (blk_ids[None, :] == q_blk_id) | (blk_ids[None, :] == q_blk_id - 1)
        imp = jnp.where(forced, FORCE_SCORE, imp)
        imp = jnp.where(blk_ids[None, :] <= q_blk_id, imp, -jnp.inf)
        _, sel = lax.top_k(imp, n_sel)
        k_sel = _gather_blocks(ksb, sel)
        v_sel = _gather_blocks(vsb, sel)
        pos = sel[..., None] * SLC_BLOCK + key_off
        ok = pos <= t[None, None, :, None, None]
        ss = jnp.einsum("bgrqd,bgqnld->bgrqnl", q_blk, k_sel).astype(jnp.float32) * scale
        ss = jnp.where(ok[:, :, None], ss, -jnp.inf).reshape(b, g, r, NSA_Q_CHUNK, n_sel * SLC_BLOCK)
        p = jax.nn.softmax(ss, axis=-1).reshape(b, g, r, NSA_Q_CHUNK, n_sel, SLC_BLOCK)
        o_slc = jnp.einsum("bgrqnl,bgqnld->bgrqd", p.astype(v_slc.dtype), v_sel)
        return o_cmp, o_slc

    o_cmp, o_slc = lax.map(chunk, (qc, jnp.arange(nq)))
    o_cmp = o_cmp.transpose(1, 0, 4, 2, 3, 5).reshape(b, s, g, r, dh)
    o_slc = o_slc.transpose(1, 0, 4, 2, 3, 5).reshape(b, s, g, r, dh)
    o_win, _ = _banded_attention(q, k_win, v_win, NSA_WINDOW)
    gw = jax.nn.sigmoid(gate_logits)
    return gw[..., 0:1] * o_cmp + gw[..., 1:2] * o_slc + gw[..., 2:3] * o_win


def _dilated_attention(q, k, v):
    b, s, _, dh = q.shape
    outs, lses = [], []
    for gi, (window, dil) in enumerate(DILATED_PAIRS):
        hs = slice(gi * C_HEADS_PER_GROUP, (gi + 1) * C_HEADS_PER_GROUP)
        n_res = -(-s // dil)
        n_res = -(-n_res // BAND_Q) * BAND_Q
        pad = ((0, 0), (0, n_res * dil - s), (0, 0), (0, 0))
        qr = jnp.pad(q[:, :, hs], pad).reshape(b, n_res, dil * C_HEADS_PER_GROUP, dh)
        kr = jnp.pad(k[:, :, hs], pad).reshape(b, n_res, dil * C_HEADS_PER_GROUP, dh)
        vr = jnp.pad(v[:, :, hs], pad).reshape(b, n_res, dil * C_HEADS_PER_GROUP, dh)
        o, lse = _banded_attention(qr[:, :, :, None], kr, vr, window // dil + 1)
        outs.append(o[:, :, :, 0].reshape(b, n_res * dil, C_HEADS_PER_GROUP, dh)[:, :s])
        lses.append(lse[..., 0].reshape(b, n_res * dil, C_HEADS_PER_GROUP)[:, :s])
    wts = jax.nn.softmax(jnp.stack(lses, 0), axis=0)
    return jnp.sum(wts[..., None].astype(q.dtype) * jnp.stack(outs, 0), axis=0)


def _clamped_swiglu(gu):
    x_glu = jnp.minimum(gu[..., ::2], SWIGLU_LIMIT)
    x_lin = jnp.clip(gu[..., 1::2], -SWIGLU_LIMIT, SWIGLU_LIMIT)
    return x_glu * jax.nn.sigmoid(SWIGLU_ALPHA * x_glu) * (x_lin + 1.0)


def _moe_ffn(h, router_w, router_b, w_gu, b_gu, w_dn, b_dn):
    n, d = h.shape
    logits = (h @ router_w + router_b).astype(jnp.float32)
    top_val, top_idx = lax.top_k(logits, TOP_K)
    gate = jax.nn.softmax(top_val, axis=-1)
    nk = n * TOP_K
    flat_e = top_idx.reshape(nk)
    flat_tok = jnp.repeat(jnp.arange(n, dtype=jnp.int32), TOP_K)
    flat_gate = gate.reshape(nk)
    order = jnp.argsort(flat_e, stable=True)
    e_sorted = flat_e[order]
    counts = jnp.bincount(flat_e, length=N_EXPERTS)
    padded = -(-counts // EXPERT_ROW_BLOCK) * EXPERT_ROW_BLOCK
    start = jnp.cumsum(counts) - counts
    pend = jnp.cumsum(padded)
    pstart = pend - padded
    dest = pstart[e_sorted] + jnp.arange(nk) - start[e_sorted]
    n_blocks = -(-(nk + N_EXPERTS * (EXPERT_ROW_BLOCK - 1)) // EXPERT_ROW_BLOCK)
    rows = n_blocks * EXPERT_ROW_BLOCK
    row_tok = jnp.zeros((rows,), jnp.int32).at[dest].set(flat_tok[order])
    row_gate = jnp.zeros((rows,), jnp.float32).at[dest].set(flat_gate[order])
    block_exp = jnp.minimum(
        jnp.searchsorted(pend, jnp.arange(n_blocks) * EXPERT_ROW_BLOCK, side="right"), N_EXPERTS - 1)

    def block(args):
        tok, g, e = args
        xb = h[tok]
        y = _clamped_swiglu(xb @ w_gu[e] + b_gu[e]) @ w_dn[e] + b_dn[e]
        return y * g[:, None].astype(y.dtype)

    y_rows = lax.map(block, (row_tok.reshape(n_blocks, EXPERT_ROW_BLOCK),
                             row_gate.reshape(n_blocks, EXPERT_ROW_BLOCK), block_exp))
    return jax.ops.segment_sum(y_rows.reshape(rows, d), row_tok, num_segments=n)


def _mixer(h, cos, sin, w_in, cmp_w1_k, cmp_w2_k, cmp_pe_k, cmp_w1_v, cmp_w2_v, cmp_pe_v,
           w_branch_a, w_branch_b, w_branch_c, w_out):
    b, s, _ = h.shape
    p = _split_in(h @ w_in)

    def heads(t, nh):
        return t.reshape(b, s, nh, HEAD_DIM)

    o_a = _moba_attention(_rope(heads(p["a_q"], A_HEADS), cos, sin),
                          _rope(heads(p["a_k"], A_HEADS), cos, sin),
                          heads(p["a_v"], A_HEADS))
    q_b = _rope(heads(p["b_q"], B_HEADS), cos, sin).reshape(b, s, B_KV_GROUPS, B_REP, HEAD_DIM)
    k_c = _nsa_compress(_rope(heads(p["b_kc"], B_KV_GROUPS), cos, sin), cmp_w1_k, cmp_w2_k, cmp_pe_k)
    v_c = _nsa_compress(heads(p["b_vc"], B_KV_GROUPS), cmp_w1_v, cmp_w2_v, cmp_pe_v)
    o_b = _nsa_attention(q_b, k_c, v_c,
                         _rope(heads(p["b_ks"], B_KV_GROUPS), cos, sin), heads(p["b_vs"], B_KV_GROUPS),
                         _rope(heads(p["b_kw"], B_KV_GROUPS), cos, sin), heads(p["b_vw"], B_KV_GROUPS),
                         p["b_gate"].reshape(b, s, B_KV_GROUPS, B_REP, N_NSA_BRANCHES))
    o_c = _dilated_attention(_rope(heads(p["c_q"], C_HEADS), cos, sin),
                             _rope(heads(p["c_k"], C_HEADS), cos, sin),
                             heads(p["c_v"], C_HEADS))
    g_a, g_b, g_c = jnp.split(jax.nn.sigmoid(p["merge_gate"]), N_BRANCHES, axis=-1)
    merged = (g_a * (o_a.reshape(b, s, -1) @ w_branch_a)
              + g_b * (o_b.reshape(b, s, -1) @ w_branch_b)
              + g_c * (o_c.reshape(b, s, -1) @ w_branch_c))
    return merged @ w_out


def setup_inputs(seed: int = 0) -> dict:
    key = jax.random.key(seed)
    ks = jax.random.split(key, 26)
    f32 = jnp.float32

    def nrm(k, shape, std):
        return jax.random.normal(k, shape, f32) * std

    col_scale = jnp.asarray(np.concatenate(
        [np.full((w,), DEEPNORM_BETA if name in V_COLUMNS else 1.0, np.float32) for name, w in IN_LAYOUT]))
    cmp_in = CMP_BLOCK * HEAD_DIM
    wa = A_HEADS * HEAD_DIM
    wb = B_HEADS * HEAD_DIM
    wc = C_HEADS_PER_GROUP * HEAD_DIM
    positions = (jax.random.randint(ks[2], (BATCH, 1), 0, MAX_POS_OFFSET)
                 + jnp.arange(SEQ)[None, :]).astype(jnp.int32)
    return {
        "x": nrm(ks[0], (BATCH, SEQ, D_MODEL), 1.0),
        "c": nrm(ks[1], (BATCH, D_MODEL), 1.0),
        "positions": positions,
        "w_ada": nrm(ks[3], (DEPTH, D_MODEL, N_ADA * D_MODEL), 0.5 * D_MODEL ** -0.5),
        "b_ada": nrm(ks[4], (DEPTH, N_ADA * D_MODEL), 0.01),
        "w_in": nrm(ks[5], (DEPTH, D_MODEL, IN_WIDTH), D_MODEL ** -0.5) * col_scale,
        "cmp_w1_k": nrm(ks[6], (DEPTH, cmp_in, CMP_HIDDEN), cmp_in ** -0.5),
        "cmp_w2_k": nrm(ks[7], (DEPTH, CMP_HIDDEN, HEAD_DIM), CMP_HIDDEN ** -0.5),
        "cmp_pe_k": nrm(ks[8], (DEPTH, CMP_BLOCK, HEAD_DIM), 0.1),
        "cmp_w1_v": nrm(ks[9], (DEPTH, cmp_in, CMP_HIDDEN), cmp_in ** -0.5),
        "cmp_w2_v": nrm(ks[10], (DEPTH, CMP_HIDDEN, HEAD_DIM), CMP_HIDDEN ** -0.5),
        "cmp_pe_v": nrm(ks[11], (DEPTH, CMP_BLOCK, HEAD_DIM), 0.1),
        "w_branch_a": nrm(ks[12], (DEPTH, wa, D_MODEL), wa ** -0.5),
        "w_branch_b": nrm(ks[13], (DEPTH, wb, D_MODEL), wb ** -0.5),
        "w_branch_c": nrm(ks[14], (DEPTH, wc, D_MODEL), wc ** -0.5),
        "w_out": nrm(ks[15], (DEPTH, D_MODEL, D_MODEL), DEEPNORM_BETA * D_MODEL ** -0.5),
        "ln1_g": 1.0 + nrm(ks[16], (DEPTH, D_MODEL), 0.02),
        "ln1_b": nrm(ks[17], (DEPTH, D_MODEL), 0.02),
        "router_w": nrm(ks[18], (DEPTH, D_MODEL, N_EXPERTS), D_MODEL ** -0.5),
        "router_b": nrm(ks[19], (DEPTH, N_EXPERTS), 0.01),
        "w_gate_up": nrm(ks[20], (DEPTH, N_EXPERTS, D_MODEL, 2 * D_EXPERT), D_MODEL ** -0.5),
        "b_gate_up": nrm(ks[21], (DEPTH, N_EXPERTS, 2 * D_EXPERT), 0.01),
        "w_down": nrm(ks[22], (DEPTH, N_EXPERTS, D_EXPERT, D_MODEL), DEEPNORM_BETA * D_EXPERT ** -0.5),
        "b_down": nrm(ks[23], (DEPTH, N_EXPERTS, D_MODEL), 0.01),
        "ln2_g": 1.0 + nrm(ks[24], (DEPTH, D_MODEL), 0.02),
        "ln2_b": nrm(ks[25], (DEPTH, D_MODEL), 0.02),
    }


def reference(x, c, positions, w_ada, b_ada, w_in, cmp_w1_k, cmp_w2_k, cmp_pe_k,
              cmp_w1_v, cmp_w2_v, cmp_pe_v, w_branch_a, w_branch_b, w_branch_c, w_out,
              ln1_g, ln1_b, router_w, router_b, w_gate_up, b_gate_up, w_down, b_down,
              ln2_g, ln2_b):
    b, s, d = x.shape
    cos, sin = _rope_tables(positions)
    cond = jax.nn.silu(c)
    for l in range(DEPTH):
        mod = (cond @ w_ada[l] + b_ada[l])[:, None, :]
        sh1, sc1, g1, sh2, sc2, g2 = jnp.split(mod, N_ADA, axis=-1)
        h = _layer_norm(x) * (1.0 + sc1) + sh1
        y = _mixer(h, cos, sin, w_in[l], cmp_w1_k[l], cmp_w2_k[l], cmp_pe_k[l],
                   cmp_w1_v[l], cmp_w2_v[l], cmp_pe_v[l],
                   w_branch_a[l], w_branch_b[l], w_branch_c[l], w_out[l])
        x = _affine_ln(DEEPNORM_ALPHA * x + g1 * y, ln1_g[l], ln1_b[l])
        h = _layer_norm(x) * (1.0 + sc2) + sh2
        y = _moe_ffn(h.reshape(b * s, d), router_w[l], router_b[l], w_gate_up[l],
                     b_gate_up[l], w_down[l], b_down[l]).reshape(b, s, d)
        x = _affine_ln(DEEPNORM_ALPHA * x + g2 * y, ln2_g[l], ln2_b[l])
    return x
```

```cpp
#include <hip/hip_runtime.h>
#include <cstdio>
#include <cstdint>
#include <cmath>
#include <cstring>

#define LAS __attribute__((address_space(3)))
#define GAS __attribute__((address_space(1)))
typedef unsigned short bf16;
typedef short bf16x8 __attribute__((ext_vector_type(8)));
typedef short s16x4 __attribute__((ext_vector_type(4)));
typedef float f32x2 __attribute__((ext_vector_type(2)));
typedef float f32x4 __attribute__((ext_vector_type(4)));
typedef float f32x16 __attribute__((ext_vector_type(16)));
typedef unsigned u32x2 __attribute__((ext_vector_type(2)));
typedef unsigned u32x4 __attribute__((ext_vector_type(4)));
typedef __bf16 bf16x2_t __attribute__((ext_vector_type(2)));
typedef int v4i32 __attribute__((ext_vector_type(4)));
typedef int v8i32 __attribute__((ext_vector_type(8)));
typedef GAS unsigned gu32;
#define DI __device__ __forceinline__
#define RLX_AGENT __ATOMIC_RELAXED, __HIP_MEMORY_SCOPE_AGENT

#ifndef PROBE_QSEL
#define PROBE_QSEL 1
#endif
#ifndef PROBE_AMASK
#define PROBE_AMASK 7
#endif
#ifndef ATT_MASK
#define ATT_MASK 7
#endif
#ifndef PHMASK
#define PHMASK 0xFFFF
#endif
#ifndef MK_ONE_LAUNCH
#define MK_ONE_LAUNCH 1
#endif

constexpr int BATCH = 8, SEQ = 4096, DM = 1024, NT = BATCH * SEQ, DEPTH = 2, HD = 64;
constexpr int PP = 6144;
constexpr int C_AQ = 0, C_AK = 256, C_BQ = 512, C_BKC = 896, C_BKS = 1024, C_BKW = 1152, C_CQ = 1280, C_CK = 1664;
constexpr int C_AV = 2048, C_BVC = 2304, C_BVS = 2432, C_BVW = 2560, C_CV = 2688, C_MG = 3072;
constexpr int O_AQ = 0, O_AK = 256, O_AV = 512, O_BQ = 768, O_BKC = 1152, O_BVC = 1280, O_BKS = 1408, O_BVS = 1536, O_BKW = 1664, O_BVW = 1792, O_BG = 1920,
              O_CQ = 1938, O_CK = 2322, O_CV = 2706, O_MG = 3090, IN_W = 6162;
constexpr unsigned QHEADS = 0x03F03F0Fu;
constexpr int NEXP = 32, TOPK = 4, MAXROWS = NT * TOPK + NEXP * 256, MAXTILES = MAXROWS / 256;
constexpr float LN_EPS = 1e-5f, ALPHA = 1.4142135623730951f  ;
constexpr float C2 = 0.125f * 1.4426950408889634f;
constexpr int NGATE = 18;

constexpr size_t MiB = 1u << 20;
constexpr size_t WS_CTL = 0, CTL_BYTES = 192 * 1024;
constexpr size_t WS_MOD = 2 * MiB;
constexpr size_t WS_WG = 3 * MiB;
constexpr size_t WS_B1 = WS_WG + 256 * 1024;
constexpr size_t WS_WRT = WS_B1 + 64 * 1024;
constexpr size_t WS_CS = 4 * MiB;
constexpr size_t WS_KM = 12 * MiB;
constexpr size_t WS_KC = WS_KM + 256 * 1024;
constexpr size_t WS_VC = WS_KC + 512 * 1024;
constexpr size_t WS_GL = 14 * MiB;
constexpr size_t WS_SELM = WS_GL + 2304 * 1024;
constexpr size_t WS_TOKE = 17 * MiB, WS_TOKG = WS_TOKE + 512 * 1024, WS_TOKO = WS_TOKG + 512 * 1024, WS_ROWG = WS_TOKO + 512 * 1024;
constexpr size_t WS_WL = 20 * MiB, WL_STRIDE = 210 * MiB;
constexpr size_t WL_IN = 0, WL_BA = 12 * MiB, WL_BB = WL_BA + 512 * 1024, WL_BC = WL_BB + 768 * 1024, WL_OUT = 14 * MiB, WL_W1K = 16 * MiB, WL_W1V = WL_W1K + 512 * 1024,
                 WL_W2K = 17 * MiB, WL_W2V = WL_W2K + 64 * 1024, WL_GU = 18 * MiB, WL_DN = 146 * MiB;
constexpr size_t WS_H = 440 * MiB;
constexpr size_t WS_PROJ = 504 * MiB;
constexpr size_t WS_OA = 888 * MiB, WS_OB = 904 * MiB, WS_OC = 928 * MiB;
constexpr size_t WS_MERGED = 944 * MiB;
constexpr size_t WS_X = 1008 * MiB;
constexpr size_t WS_ACT = 1136 * MiB;
constexpr size_t WS_KF = 1408 * MiB;
constexpr size_t WS_RT = 1466 * MiB;
constexpr size_t WS_H8 = 1476 * MiB;
constexpr size_t WS_G8 = 1508 * MiB;
constexpr size_t WS_END = 1604 * MiB;
constexpr int CW_BAR = 4096, CW_Q = 8192, CW_CUR = 32768;
constexpr int RING_BYTES = 131072, MISC_OFF = RING_BYTES, LDS_BYTES = 147456;

DI unsigned cvt_pk(float lo, float hi) { f32x2 v = {lo, hi}; bf16x2_t b = __builtin_convertvector(v, bf16x2_t); return __builtin_bit_cast(unsigned, b); }
DI unsigned cvt_fp8x4(float a, float b, float c, float d) {
    a = fminf(fmaxf(a, -448.f), 448.f); b = fminf(fmaxf(b, -448.f), 448.f); c = fminf(fmaxf(c, -448.f), 448.f); d = fminf(fmaxf(d, -448.f), 448.f);
    int w = __builtin_amdgcn_cvt_pk_fp8_f32(a, b, 0, false); w = __builtin_amdgcn_cvt_pk_fp8_f32(c, d, w, true); return (unsigned)w; }
DI float bf_lo(unsigned w) { return __uint_as_float(w << 16); }
DI float bf_hi(unsigned w) { return __uint_as_float(w & 0xffff0000u); }
template <int CTRL> DI float dpp_f(float v) { return __int_as_float(__builtin_amdgcn_update_dpp(0, __float_as_int(v), CTRL, 0xF, 0xF, true)); }
DI float wave_sum(float v) {
    v += dpp_f<0xB1>(v);
    v += dpp_f<0x4E>(v);
    v += dpp_f<0x141>(v);
    v += dpp_f<0x140>(v);
    const float s0 = __int_as_float(__builtin_amdgcn_readlane(__float_as_int(v), 0)), s1 = __int_as_float(__builtin_amdgcn_readlane(__float_as_int(v), 16));
    const float s2 = __int_as_float(__builtin_amdgcn_readlane(__float_as_int(v), 32)), s3 = __int_as_float(__builtin_amdgcn_readlane(__float_as_int(v), 48));
    return (s0 + s1) + (s2 + s3);
}
template <int CTRL> DI int dpp_i(int v) { return __builtin_amdgcn_update_dpp(0, v, CTRL, 0xF, 0xF, true); }
DI float xrow_sum(float v) {
    v += __shfl_xor(v, 16);
    auto rr = __builtin_amdgcn_permlane32_swap(__float_as_uint(v), __float_as_uint(v), false, false); return __uint_as_float(rr[0]) + __uint_as_float(rr[1]);
}
DI float reduce_scatter8(float (&v)[8], int lane) {
    float c4[4], d2[2];
    { const bool up = lane & 8;
#pragma unroll
      for (int i = 0; i < 4; ++i) { const float keep = up ? v[4 + i] : v[i], send = up ? v[i] : v[4 + i]; c4[i] = keep + dpp_f<0x140>(send); } }
    { const bool up = lane & 4;
#pragma unroll
      for (int i = 0; i < 2; ++i) { const float keep = up ? c4[2 + i] : c4[i], send = up ? c4[i] : c4[2 + i]; d2[i] = keep + dpp_f<0x141>(send); } }
    float e1; { const bool up = lane & 2; const float keep = up ? d2[1] : d2[0], send = up ? d2[0] : d2[1]; e1 = keep + dpp_f<0x4E>(send); }
    e1 += dpp_f<0xB1>(e1);
    return xrow_sum(e1);
}
DI float reduce_scatter16(float (&v)[16], int lane) {
    float a8[8], c4[4], d2[2];
    { const bool up = lane & 8;
#pragma unroll
      for (int i = 0; i < 8; ++i) { const float keep = up ? v[8 + i] : v[i], send = up ? v[i] : v[8 + i]; a8[i] = keep + dpp_f<0x140>(send); } }
    { const bool up = lane & 4;
#pragma unroll
      for (int i = 0; i < 4; ++i) { const float keep = up ? a8[4 + i] : a8[i], send = up ? a8[i] : a8[4 + i]; c4[i] = keep + dpp_f<0x141>(send); } }
    { const bool up = lane & 2;
#pragma unroll
      for (int i = 0; i < 2; ++i) { const float keep = up ? c4[2 + i] : c4[i], send = up ? c4[i] : c4[2 + i]; d2[i] = keep + dpp_f<0x4E>(send); } }
    float e1; { const bool up = lane & 1; const float keep = up ? d2[1] : d2[0], send = up ? d2[0] : d2[1]; e1 = keep + dpp_f<0xB1>(send); }
    return xrow_sum(e1);
}

DI float fast_exp(float x) { return __builtin_amdgcn_exp2f(x * 1.4426950408889634f); }
DI float sigmoidf_(float x) { return __builtin_amdgcn_rcpf(1.0f + fast_exp(-x)); }
#define LDS_WAIT() asm volatile("s_waitcnt lgkmcnt(0)" ::: "memory")
#define VM_WAIT() asm volatile("s_waitcnt vmcnt(0)" ::: "memory")

#define XB_TMO      128
#define XB_XCNT(j)  (256  + 64 * (j))
#define XB_XSUB(j)  (1280 + 64 * (j))
#define XB_XGEN(j)  (2304 + 64 * (j))
#define XB_TOP      3328
#define XB_TOPGEN   3392
#define XCD_BAR_WORDS 3456
#define XB_SPIN_CAP (1u << 22)
DI unsigned xb_ld(unsigned* p)              { return __hip_atomic_load(p, __ATOMIC_RELAXED, __HIP_MEMORY_SCOPE_AGENT); }
DI unsigned xb_add(unsigned* p, unsigned v) { return __hip_atomic_fetch_add(p, v, __ATOMIC_RELAXED, __HIP_MEMORY_SCOPE_AGENT); }
DI unsigned xb_xcc_id() { return (unsigned)__builtin_amdgcn_s_getreg((3 << 11) | 20) & 0xFu; }
#define XB_SPIN(cond, bar) do { unsigned _sp = 0; while (cond) { __builtin_amdgcn_s_sleep(1); \
    if ((++_sp & 255u) == 0u) { if (xb_ld(&(bar)[XB_TMO])) break; if (_sp > XB_SPIN_CAP) { atomicAdd(&(bar)[XB_TMO], 1u); break; } } } } while (0)
struct XcdBarrier { unsigned* bar; unsigned x; volatile LAS unsigned* st; };
DI XcdBarrier xcd_barrier_post(unsigned* bar, volatile LAS unsigned* st) {
    XcdBarrier b; b.bar = bar; b.x = xb_xcc_id(); b.st = st;
    if (threadIdx.x == 0) (void)xb_add(&bar[XB_XCNT(b.x)], 1u);
    return b;
}
DI void xcd_barrier_complete(unsigned* bar, unsigned x, unsigned& nloc, unsigned& nx) {
    const unsigned G = gridDim.x * gridDim.y * gridDim.z;
    unsigned sum, cnt, mine, sp = 0u;
    for (;;) {
        sum = 0u; cnt = 0u; mine = 0u;
#pragma unroll
        for (unsigned j = 0; j < 16; ++j) { const unsigned c = xb_ld(&bar[XB_XCNT(j)]); sum += c; cnt += (c > 0u) ? 1u : 0u; mine = (j == x) ? c : mine; }
        if (sum == G) break;
        __builtin_amdgcn_s_sleep(1);
        if ((++sp & 255u) == 0u) { if (xb_ld(&bar[XB_TMO])) break; if (sp > XB_SPIN_CAP) { atomicAdd(&bar[XB_TMO], 1u); break; } }
    }
    nloc = mine > 0u ? mine : 1u; nx = cnt > 0u ? cnt : 1u;
}
DI void xcd_barrier(const XcdBarrier& b) {
    asm volatile("s_waitcnt vmcnt(0)" ::: "memory");
    __syncthreads();
    if (threadIdx.x == 0) {
        unsigned* bar = b.bar; unsigned bx_ = b.x; asm volatile("" : "+s"(bar), "+s"(bx_));
        __builtin_amdgcn_s_waitcnt(0);
        unsigned nloc = b.st[0], nx = b.st[1];
        if (nloc == 0u) { xcd_barrier_complete(bar, bx_, nloc, nx); b.st[0] = nloc; b.st[1] = nx; }
        const unsigned old = xb_add(&bar[XB_XSUB(bx_)], 1u);
        const unsigned gen = old / nloc;
        if (old + 1u == (gen + 1u) * nloc) {
            __builtin_amdgcn_fence(__ATOMIC_RELEASE, "agent");
            asm volatile("s_waitcnt vmcnt(0)" ::: "memory");
            const unsigned og = xb_add(&bar[XB_TOP], 1u);
            const unsigned tg = og / nx;
            if (og + 1u == (tg + 1u) * nx) xb_add(&bar[XB_TOPGEN], 1u);
            else XB_SPIN(xb_ld(&bar[XB_TOPGEN]) == tg, bar);
            __builtin_amdgcn_fence(__ATOMIC_ACQUIRE, "agent");
            xb_add(&bar[XB_XGEN(bx_)], 1u);
            asm volatile("s_waitcnt vmcnt(0)" ::: "memory");
        } else {
            XB_SPIN(xb_ld(&bar[XB_XGEN(bx_)]) == gen, bar);
            __builtin_amdgcn_fence(__ATOMIC_ACQUIRE, "agent");
            asm volatile("s_waitcnt vmcnt(0)" ::: "memory");
        }
    }
    __syncthreads();
}

namespace pg8 {
constexpr int BM = 256, BK = 64, HALF = 128, HTB = HALF * BK * 2, STAGE_BYTES = 8 * HTB, NXCD = 8, WGM = 8;
__host__ __device__ __forceinline__ int lds_byte(int r, int c) { const int st = (r >> 4) * 2 + (c >> 5), rr = r & 15, cc = c & 31, ob = rr * 64 + cc * 2; return st * 1024 + (ob ^ (((ob >> 9) & 1) << 5)); }
__host__ __device__ __forceinline__ void stage_rc(int b, int& R, int& C) { const int st = b / 1024, sb = b % 1024, swz = sb ^ (((sb >> 9) & 1) << 5); R = (st >> 1) * 16 + swz / 64; C = (st & 1) * 32 + (swz % 64) / 2; }
__host__ __device__ __forceinline__ int perm32(int rho) { const int n = rho >> 4, i = rho & 15; return 8 * (i >> 2) + 4 * n + (i & 3); }

struct Unit { int pm, pn, e, r0, cnt; const char* a; const char* b; };

struct TileOrder {
    int nM, nN, nwg, G, c; const char* A; const char* Bt; size_t tstep, estride; const LAS unsigned char* texp; const LAS int* pstart; const LAS int* ecnt; const int* rowtok; bool gather; bool noepi = false;
    DI void init(const void* A_, const void* Bt_, int nM_, int nN_, int K, int G_, int c_, size_t estride_ = 0, const LAS unsigned char* texp_ = nullptr, const LAS int* pstart_ = nullptr, const LAS int* ecnt_ = nullptr,
                 const int* rowtok_ = nullptr, bool gather_ = false) {
        A = (const char*)A_; Bt = (const char*)Bt_; nM = nM_; nN = nN_; nwg = nM * nN; G = G_; c = c_; tstep = (size_t)BM * K * 2; estride = estride_; texp = texp_; pstart = pstart_; ecnt = ecnt_; rowtok = rowtok_; gather = gather_; }
    DI bool next(int i, Unit& u) const {
        const long L = (long)i * G + c; if (L >= nwg) return false;
        int wgid = (int)L; { const int q = nwg / NXCD, r = nwg % NXCD, xcd = wgid % NXCD, off = wgid / NXCD; wgid = (xcd < r ? xcd * (q + 1) : r * (q + 1) + (xcd - r) * q) + off; }
        int gid, rem;
        if (nN == 4) { gid = wgid / 32; rem = wgid % 32; } else if (nN == 8) { gid = wgid / 64; rem = wgid % 64; } else if (nN == 16) { gid = wgid / 128; rem = wgid % 128; } else if (nN == 24) { gid = wgid / 192; rem = wgid % 192; }
        else { const int nig = WGM * nN; gid = wgid / nig; rem = wgid % nig; }
        const int fm = gid * WGM, gsz = (nM - fm) < WGM ? (nM - fm) : WGM;
        if (gsz == WGM) { u.pm = fm + (rem & 7); u.pn = rem >> 3; } else { u.pm = fm + (rem % gsz); u.pn = rem / gsz; }
        u.e = texp ? __builtin_amdgcn_readfirstlane((int)texp[u.pm]) : 0;
        u.r0 = 0; u.cnt = 0;
        if (texp) { u.r0 = u.pm * BM - __builtin_amdgcn_readfirstlane(pstart[u.e]); u.cnt = __builtin_amdgcn_readfirstlane(ecnt[u.e]); }
        u.a = gather ? A : A + (size_t)u.pm * tstep; u.b = Bt + (size_t)u.e * estride + (size_t)u.pn * tstep; return true;
    }
};

template <class Epi, bool ALIGN_EPI = true, bool GATHER = false, bool FP8 = false>
DI void gemm_phase(LAS unsigned char* lds, const int K, const TileOrder& S, const Epi& E, int tid_in) {
    int tid = tid_in; asm volatile("" : "+v"(tid));
    const int wid = __builtin_amdgcn_readfirstlane(tid >> 6), lane = tid & 63, wr = wid >> 2, wc = wid & 3, fr = lane & 15, fq = lane >> 4;
    const int nt = K / BK;
    unsigned voffA[2], voffB[2];
#pragma unroll
    for (int i = 0; i < 2; ++i) { int R, C; stage_rc(tid * 16 + i * 8192, R, C); const int Rb = Epi::PERM ? ((R & ~31) + perm32(R & 31)) : R;
        voffA[i] = GATHER ? (unsigned)C * 2u : (unsigned)(R * K + C) * 2u; voffB[i] = (unsigned)(Rb * K + C) * 2u; }
    LAS unsigned* gslot = (LAS unsigned*)(lds + MISC_OFF + 8192) + tid * 2;
    unsigned gid[4] = {0u, 0u, 0u, 0u};
    auto gather_ld = [&](const Unit& u) {
        int t2 = tid; asm volatile("" : "+v"(t2)); int R0, R1, C_; stage_rc(t2 * 16, R0, C_); stage_rc(t2 * 16 + 8192, R1, C_);
#pragma unroll
        for (int h = 0; h < 2; ++h) { const int o0 = u.r0 + h * HALF + R0, o1 = u.r0 + h * HALF + R1;
            gid[2 * h] = o0 < u.cnt ? (unsigned)S.rowtok[(size_t)u.e * 32768 + o0] : 0u; gid[2 * h + 1] = o1 < u.cnt ? (unsigned)S.rowtok[(size_t)u.e * 32768 + o1] : 0u; } };
    auto gather_commit = [&](int nxt_) { gslot[nxt_ * 1024] = gid[0] | (gid[1] << 16); gslot[nxt_ * 1024 + 1] = gid[2] | (gid[3] << 16); };
    const size_t kstep = (size_t)(BK * 2);
    const size_t hstep = (size_t)HALF * K * 2;
    const unsigned ldsw = (unsigned)wid * 1024u;
    const int aoff = lds_byte(wr * 64 + fr, fq * 8), boff = lds_byte(wc * 32 + fr, fq * 8);
#define PG8_SA(b, h) (((b) * 2 + (h)) * HTB)
#define PG8_SB(b, h) ((4 + (b) * 2 + (h)) * HTB)
#define PG8_STAGE(bufoff, gbase, voff) do { _Pragma("unroll") for (int _i = 0; _i < 2; ++_i) \
        __builtin_amdgcn_global_load_lds((const unsigned*)((const char*)(gbase) + (voff)[_i]), (LAS unsigned*)(lds + (bufoff) + ldsw + _i * 8192), 16, 0, 0); } while (0)
#define PG8_STAGE_A(bufoff, h, gb, nx) do { if constexpr (GATHER) { const unsigned _w = gslot[((nx) ? 1024 : 0) + (h)]; unsigned _vo[2] = {(_w & 0xffffu) * (unsigned)(K * 2) + voffA[0], (_w >> 16) * (unsigned)(K * 2) + voffA[1]}; PG8_STAGE(bufoff, gb, _vo); } \
        else { PG8_STAGE(bufoff, (gb) + (h) * hstep, voffA); } } while (0)
#define PG8_LDA(dst, b, h) do { _Pragma("unroll") for (int m = 0; m < 4; ++m) { if constexpr (FP8) { dst##8[m].lo = *(const LAS v4i32*)(lds + PG8_SA(b, h) + aoff + m * 2048); dst##8[m].hi = *(const LAS v4i32*)(lds + PG8_SA(b, h) + aoff + m * 2048 + 1024); } \
        else { _Pragma("unroll") for (int k = 0; k < 2; ++k) dst[m][k] = *(const LAS bf16x8*)(lds + PG8_SA(b, h) + aoff + m * 2048 + k * 1024); } } } while (0)
#define PG8_LDB(dst, b, h) do { _Pragma("unroll") for (int n = 0; n < 2; ++n) { if constexpr (FP8) { dst##8[n].lo = *(const LAS v4i32*)(lds + PG8_SB(b, h) + boff + n * 2048); dst##8[n].hi = *(const LAS v4i32*)(lds + PG8_SB(b, h) + boff + n * 2048 + 1024); } \
        else { _Pragma("unroll") for (int k = 0; k < 2; ++k) dst[n][k] = *(const LAS bf16x8*)(lds + PG8_SB(b, h) + boff + n * 2048 + k * 1024); } } } while (0)
#define PG8_MMA(ai, bj, At, Bt) do { __builtin_amdgcn_s_setprio(1); _Pragma("unroll") for (int m = 0; m < 4; ++m) _Pragma("unroll") for (int n = 0; n < 2; ++n) { \
        if constexpr (FP8) { asm volatile("v_mfma_scale_f32_16x16x128_f8f6f4 %0, %1, %2, %0, %3, %3 op_sel_hi:[0,0,0]" : "+v"(acc[ai][bj][m][n]) : "v"(Bt##8[n]), "v"(At##8[m]), "v"(fp8_one)); } \
        else { _Pragma("unroll") for (int k = 0; k < 2; ++k) acc[ai][bj][m][n] = __builtin_amdgcn_mfma_f32_16x16x32_bf16(Bt[n][k], At[m][k], acc[ai][bj][m][n], 0, 0, 0); } } __builtin_amdgcn_s_setprio(0); } while (0)
#define PG8_WAIT_V(n) asm volatile("s_waitcnt vmcnt(" #n ")" ::: "memory")
#define PG8_WAIT_L(n) asm volatile("s_waitcnt lgkmcnt(" #n ")" ::: "memory")
#define PG8_BAR __builtin_amdgcn_s_barrier()
#define PG8_SCHED __builtin_amdgcn_sched_barrier(0)
    Unit cur, nxt; int ui = 0;
    if (!S.next(0, cur)) return;
    f32x4 acc[2][2][4][2];
#pragma unroll
    for (int a = 0; a < 2; ++a)
#pragma unroll
        for (int b = 0; b < 2; ++b)
#pragma unroll
            for (int m = 0; m < 4; ++m)
#pragma unroll
                for (int n = 0; n < 2; ++n) acc[a][b][m][n] = (f32x4){0.f, 0.f, 0.f, 0.f};
    const int fp8_one = 0x7F7F7F7F;
    bf16x8 At[4][2], B0[2][2], B1[2][2]; v8i32 At8[4], B08[2], B18[2];
    const char* cA = cur.a; const char* cB = cur.b;
    if constexpr (GATHER) { gather_ld(cur); gather_commit(0); }
    PG8_STAGE(PG8_SB(0, 0), cB, voffB); PG8_STAGE(PG8_SB(0, 1), cB + hstep, voffB); PG8_STAGE_A(PG8_SA(0, 0), 0, cA, false); PG8_STAGE_A(PG8_SA(0, 1), 1, cA, false);
    if (wr == 1) PG8_BAR;
    PG8_WAIT_V(2); PG8_BAR;
    PG8_STAGE(PG8_SB(1, 0), cB + kstep, voffB); PG8_STAGE_A(PG8_SA(1, 0), 0, cA + kstep, false); PG8_STAGE(PG8_SB(1, 1), cB + hstep + kstep, voffB);
    PG8_WAIT_V(6); PG8_BAR;
    for (;;) {
        const bool has_next = S.next(ui + 1, nxt);
        const char* nA = has_next ? nxt.a : cA; const char* nB = has_next ? nxt.b : cB;
        if constexpr (GATHER) { if (has_next) gather_ld(nxt); }
#pragma nounroll
        for (int t = 0; t < nt; t += 2) {
            if constexpr (Epi::HOOK) { if (t == Epi::HOOK_T0 || t == Epi::HOOK_T1) { PG8_SCHED; if constexpr (FP8) asm volatile("s_nop 15\n\ts_nop 15" ::: "memory"); E.hook(acc, cur, t, wr, wc, fr, fq); if constexpr (FP8) asm volatile("s_nop 7" ::: "memory"); PG8_SCHED; } }
            if constexpr (GATHER) { if (t == 2 && has_next) gather_commit(1); }
            const bool last = (t == nt - 2);
            const char* a1 = cA + (size_t)(t + 1) * kstep;
            const char* a2 = last ? nA : cA + (size_t)(t + 2) * kstep; const char* b2 = last ? nB : cB + (size_t)(t + 2) * kstep;
            const char* a3 = a2 + kstep; const char* b3 = b2 + kstep;
            const bool nx = last && has_next;
            PG8_LDB(B0, 0, 0); PG8_LDB(B1, 0, 1); PG8_SCHED; PG8_LDA(At, 0, 0); PG8_STAGE_A(PG8_SA(1, 1), 1, a1, false);
            PG8_WAIT_V(8); PG8_WAIT_L(0); PG8_BAR; PG8_MMA(0, 0, At, B0); PG8_MMA(0, 1, At, B1); PG8_BAR; PG8_SCHED;
            PG8_LDA(At, 0, 1); PG8_STAGE(PG8_SB(0, 0), b2, voffB); PG8_STAGE(PG8_SB(0, 1), b2 + hstep, voffB); PG8_STAGE_A(PG8_SA(0, 0), 0, a2, nx);
            PG8_WAIT_V(8); PG8_WAIT_L(0); PG8_BAR; PG8_MMA(1, 0, At, B0); PG8_MMA(1, 1, At, B1); PG8_BAR; PG8_SCHED;
            PG8_LDB(B0, 1, 0); PG8_LDB(B1, 1, 1); PG8_SCHED; PG8_LDA(At, 1, 0); PG8_STAGE_A(PG8_SA(0, 1), 1, a2, nx);
            PG8_WAIT_V(8); PG8_WAIT_L(0); PG8_BAR; PG8_MMA(0, 0, At, B0); PG8_MMA(0, 1, At, B1); PG8_BAR; PG8_SCHED;
            PG8_LDA(At, 1, 1); PG8_STAGE(PG8_SB(1, 0), b3, voffB); PG8_STAGE(PG8_SB(1, 1), b3 + hstep, voffB); PG8_STAGE_A(PG8_SA(1, 0), 0, a3, nx);
            PG8_WAIT_V(8); PG8_WAIT_L(0); PG8_BAR; PG8_MMA(1, 0, At, B0); PG8_MMA(1, 1, At, B1); PG8_BAR; PG8_SCHED;
        }
        if constexpr (ALIGN_EPI) { if (wr == 0) PG8_BAR; }
        if constexpr (FP8) asm volatile("s_nop 15\n\ts_nop 15" ::: "memory");
        if (!S.noepi) E(acc, cur, wr, wc, fr, fq);
        if (!has_next) break;
#pragma unroll
        for (int a = 0; a < 2; ++a)
#pragma unroll
            for (int b = 0; b < 2; ++b)
#pragma unroll
                for (int m = 0; m < 4; ++m)
#pragma unroll
                    for (int n = 0; n < 2; ++n) acc[a][b][m][n] = (f32x4){0.f, 0.f, 0.f, 0.f};
        cur = nxt; cA = nA; cB = nB; ++ui;
        if constexpr (GATHER) { gslot[0] = gslot[1024]; gslot[1] = gslot[1025]; }
        if constexpr (ALIGN_EPI) { if (wr == 1) PG8_BAR; }
    }
    PG8_WAIT_V(0);
    if constexpr (!ALIGN_EPI) { if (wr == 0) PG8_BAR; }
    PG8_BAR;
#undef PG8_SA
#undef PG8_SB
#undef PG8_STAGE
#undef PG8_STAGE_A
#undef PG8_LDA
#undef PG8_LDB
#undef PG8_MMA
#undef PG8_WAIT_V
#undef PG8_WAIT_L
#undef PG8_BAR
#undef PG8_SCHED
}
}

typedef f32x4 Acc[2][2][4][2];
constexpr float S_H = 16.0f, S_WGU = 1024.0f, S_ACT = 4.0f, S_WDN = 2048.0f, S_WIN = 1024.0f, S_MG = 128.0f, S_WOUT = 2048.0f, S_G = 64.0f, S_Y = 64.0f, S_O = 128.0f, S_WB = 256.0f;

struct EpiProj {
    static constexpr bool PERM = true, HOOK = false; static constexpr int HOOK_T0 = -1, HOOK_T1 = -1;
    bf16* O; const float* cosT; const float* sinT; bf16* KF; int pn_off; float dq; unsigned char* G8;
    DI void operator()(const Acc& acc, const pg8::Unit& u, int wr, int wc, int fr, int fq) const {
        const int pnt = u.pn + pn_off;
        const int row0 = u.pm * 256 + wr * 64 + fr, col0 = pnt * 256 + wc * 32 + 8 * fq;
        if (pnt < 8) {
            const int i0 = 16 * (wc & 1) + 4 * fq;
#pragma unroll
            for (int ai = 0; ai < 2; ++ai)
#pragma unroll
                for (int m = 0; m < 4; ++m) {
                    const int row = row0 + ai * 128 + m * 16;
                    const f32x4 cs = *(const f32x4*)(cosT + (size_t)row * 32 + i0), sn = *(const f32x4*)(sinT + (size_t)row * 32 + i0);
#pragma unroll
                    for (int bj = 0; bj < 2; ++bj) {
                        const int col = col0 + bj * 128; const float sc = ((QHEADS >> (col >> 6)) & 1u) ? C2 : 1.0f;
                        const f32x4 v0 = acc[ai][bj][m][0] * dq, v1 = acc[ai][bj][m][1] * dq;
                        u32x4 w;
                        w.x = cvt_pk((v0[0] * cs[0] - v0[1] * sn[0]) * sc, (v0[1] * cs[0] + v0[0] * sn[0]) * sc);
                        w.y = cvt_pk((v0[2] * cs[1] - v0[3] * sn[1]) * sc, (v0[3] * cs[1] + v0[2] * sn[1]) * sc);
                        w.z = cvt_pk((v1[0] * cs[2] - v1[1] * sn[2]) * sc, (v1[1] * cs[2] + v1[0] * sn[2]) * sc);
                        w.w = cvt_pk((v1[2] * cs[3] - v1[3] * sn[3]) * sc, (v1[3] * cs[3] + v1[2] * sn[3]) * sc);
                        int kh = -1;
                        if (col >= C_AK && col < C_BQ) kh = (col - C_AK) >> 6; else if (col >= C_BKS && col < C_CQ) kh = 4 + ((col - C_BKS) >> 6); else if (col >= C_CK) kh = 8 + ((col - C_CK) >> 6);
                        if (kh >= 0) {
                            const int sl = kh < 10 ? 0 : (kh < 12 ? 2 : 4);
                            const int t = row & (SEQ - 1), b = row >> 12, cls = t & ((1 << sl) - 1), mm = t >> sl, tile = cls * (128 >> sl) + (mm >> 5), d0 = col & 63;
                            *(u32x4*)(KF + ((size_t)((b * 14 + kh) * 128 + tile)) * 2048 + (d0 >> 4) * 512 + ((d0 >> 3) & 1) * 256 + (mm & 31) * 8) = w;
                        } else *(u32x4*)(O + (size_t)row * PP + col) = w;
                    }
                }
        } else {
            const bool sg = pnt >= 12;
#pragma unroll
            for (int ai = 0; ai < 2; ++ai)
#pragma unroll
                for (int m = 0; m < 4; ++m) {
                    const int row = row0 + ai * 128 + m * 16;
#pragma unroll
                    for (int bj = 0; bj < 2; ++bj) {
                        f32x4 v0 = acc[ai][bj][m][0] * dq, v1 = acc[ai][bj][m][1] * dq;
                        if (sg) {
#pragma unroll
                            for (int j = 0; j < 4; ++j) { v0[j] = sigmoidf_(v0[j]); v1[j] = sigmoidf_(v1[j]); }
                        }
                        if (sg) { u32x2 w; w.x = cvt_fp8x4(v0[0] * S_G, v0[1] * S_G, v0[2] * S_G, v0[3] * S_G); w.y = cvt_fp8x4(v1[0] * S_G, v1[1] * S_G, v1[2] * S_G, v1[3] * S_G);
                            *(u32x2*)(G8 + (size_t)row * 3072 + (col0 + bj * 128 - C_MG)) = w; }
                        else { u32x4 w; w.x = cvt_pk(v0[0], v0[1]); w.y = cvt_pk(v0[2], v0[3]); w.z = cvt_pk(v1[0], v1[1]); w.w = cvt_pk(v1[2], v1[3]);
                            *(u32x4*)(O + (size_t)row * PP + col0 + bj * 128) = w; }
                    }
                }
        }
    }
};

struct EpiBranchF {
    static constexpr bool PERM = true, HOOK = true; static constexpr int HOOK_T0 = 2, HOOK_T1 = 4;
    bf16* Mg; const unsigned char* G;
    DI static void unpack8(float (&f)[8], const u32x2 g) {
        f[0] = __builtin_amdgcn_cvt_f32_fp8((int)g.x, 0); f[1] = __builtin_amdgcn_cvt_f32_fp8((int)g.x, 1); f[2] = __builtin_amdgcn_cvt_f32_fp8((int)g.x, 2); f[3] = __builtin_amdgcn_cvt_f32_fp8((int)g.x, 3);
        f[4] = __builtin_amdgcn_cvt_f32_fp8((int)g.y, 0); f[5] = __builtin_amdgcn_cvt_f32_fp8((int)g.y, 1); f[6] = __builtin_amdgcn_cvt_f32_fp8((int)g.y, 2); f[7] = __builtin_amdgcn_cvt_f32_fp8((int)g.y, 3); }
    DI void hook(Acc& acc, const pg8::Unit& u, int t, int wr, int wc, int fr_in, int fq_in) const {
        int fr = fr_in, fq = fq_in; asm volatile("" : "+v"(fr), "+v"(fq));
        const int row0 = u.pm * 256 + wr * 64 + fr, col0 = u.pn * 256 + wc * 32 + 8 * fq;
        const unsigned char* gp = G + (t == HOOK_T0 ? 0 : 2 * DM);
        const int gnext = (t == HOOK_T0 ? 2 * DM : -DM);
#pragma unroll
        for (int ai = 0; ai < 2; ++ai) {
            u32x2 gpv[4][2], gnv[4][2];
#pragma unroll
            for (int m = 0; m < 4; ++m)
#pragma unroll
                for (int bj = 0; bj < 2; ++bj) { const unsigned char* p = gp + (size_t)(row0 + ai * 128 + m * 16) * 3072 + col0 + bj * 128; gpv[m][bj] = *(const u32x2*)p; gnv[m][bj] = *(const u32x2*)(p + gnext); }
#pragma unroll
            for (int m = 0; m < 4; ++m)
#pragma unroll
                for (int bj = 0; bj < 2; ++bj) { float gp8[8], gn8[8]; unpack8(gp8, gpv[m][bj]); unpack8(gn8, gnv[m][bj]);
#pragma unroll
                    for (int j = 0; j < 4; ++j) { acc[ai][bj][m][0][j] *= fmaxf(gp8[j], 1e-20f) * __builtin_amdgcn_rcpf(fmaxf(gn8[j], 1e-20f)); acc[ai][bj][m][1][j] *= fmaxf(gp8[4 + j], 1e-20f) * __builtin_amdgcn_rcpf(fmaxf(gn8[4 + j], 1e-20f)); } }
            asm volatile("" ::: "memory");
        }
    }
    DI void operator()(const Acc& acc, const pg8::Unit& u, int wr, int wc, int fr, int fq) const {
        const int row0 = u.pm * 256 + wr * 64 + fr, col0 = u.pn * 256 + wc * 32 + 8 * fq;
#pragma unroll
        for (int ai = 0; ai < 2; ++ai)
#pragma unroll
            for (int m = 0; m < 4; ++m) {
                const int row = row0 + ai * 128 + m * 16;
#pragma unroll
                for (int bj = 0; bj < 2; ++bj) {
                    const int col = col0 + bj * 128;
                    float g8[8]; unpack8(g8, *(const u32x2*)(G + DM + (size_t)row * 3072 + col));
#pragma unroll
                    for (int j = 0; j < 8; ++j) g8[j] = fmaxf(g8[j], 1e-20f) * (1.0f / (S_G * S_O * S_WB));
                    const f32x4 v0 = acc[ai][bj][m][0], v1 = acc[ai][bj][m][1];
                    u32x2 w; w.x = cvt_fp8x4(v0[0] * g8[0] * S_MG, v0[1] * g8[1] * S_MG, v0[2] * g8[2] * S_MG, v0[3] * g8[3] * S_MG);
                    w.y = cvt_fp8x4(v1[0] * g8[4] * S_MG, v1[1] * g8[5] * S_MG, v1[2] * g8[6] * S_MG, v1[3] * g8[7] * S_MG);
                    *(u32x2*)((unsigned char*)Mg + (size_t)row * DM + col) = w;
                }
            }
    }
};

struct EpiOut {
    static constexpr bool PERM = true, HOOK = false; static constexpr int HOOK_T0 = -1, HOOK_T1 = -1;
    bf16* Y;
    DI void operator()(const Acc& acc, const pg8::Unit& u, int wr, int wc, int fr, int fq) const {
        const int row0 = u.pm * 256 + wr * 64 + fr, col0 = u.pn * 256 + wc * 32 + 8 * fq;
#pragma unroll
        for (int ai = 0; ai < 2; ++ai)
#pragma unroll
            for (int m = 0; m < 4; ++m) {
                const int row = row0 + ai * 128 + m * 16;
#pragma unroll
                for (int bj = 0; bj < 2; ++bj) { constexpr float dq = 1.0f / (S_MG * S_WOUT); const f32x4 v0 = acc[ai][bj][m][0] * dq, v1 = acc[ai][bj][m][1] * dq;
                    u32x4 w; w.x = cvt_pk(v0[0], v0[1]); w.y = cvt_pk(v0[2], v0[3]); w.z = cvt_pk(v1[0], v1[1]); w.w = cvt_pk(v1[2], v1[3]);
                    *(u32x4*)(Y + (size_t)row * DM + col0 + bj * 128) = w; }
            }
    }
};

struct EpiGU {
    static constexpr bool PERM = true, HOOK = false; static constexpr int HOOK_T0 = -1, HOOK_T1 = -1;
    unsigned char* ACT; const float* bgu;
    DI void operator()(const Acc& acc, const pg8::Unit& u, int wr, int wc, int fr_in, int fq_in) const {
        int fr = fr_in, fq = fq_in; asm volatile("" : "+v"(fr), "+v"(fq));
        const int row0 = u.pm * 256 + wr * 64 + fr, col0 = u.pn * 256 + wc * 32 + 8 * fq;
        const float* bb = bgu + (size_t)u.e * 2048;
        constexpr float dq = 1.0f / (S_H * S_WGU);
        f32x4 bv[2][2];
#pragma unroll
        for (int bj = 0; bj < 2; ++bj)
#pragma unroll
            for (int n = 0; n < 2; ++n) bv[bj][n] = *(const f32x4*)(bb + col0 + bj * 128 + 4 * n);
#pragma unroll
        for (int ai = 0; ai < 2; ++ai)
#pragma unroll
            for (int m = 0; m < 4; ++m) {
                const int row = row0 + ai * 128 + m * 16;
#pragma unroll
                for (int bj = 0; bj < 2; ++bj) {
                    const f32x4 v0 = acc[ai][bj][m][0] * dq + bv[bj][0], v1 = acc[ai][bj][m][1] * dq + bv[bj][1];
                    const float gl[4] = {v0[0], v0[2], v1[0], v1[2]}, ln[4] = {v0[1], v0[3], v1[1], v1[3]};
                    float o[4];
#pragma unroll
                    for (int j = 0; j < 4; ++j) { const float g = fminf(gl[j], 7.0f), l = fminf(fmaxf(ln[j], -7.0f), 7.0f); o[j] = g * sigmoidf_(1.702f * g) * (l + 1.0f) * S_ACT; }
                    *(unsigned*)(ACT + (size_t)row * DM + ((col0 + bj * 128) >> 1)) = cvt_fp8x4(o[0], o[1], o[2], o[3]);
                }
            }
    }
};

struct EpiDN {
    static constexpr bool PERM = true, HOOK = false; static constexpr int HOOK_T0 = -1, HOOK_T1 = -1;
    bf16* YR; const float* bdn; const float* rowg;
    DI void operator()(const Acc& acc, const pg8::Unit& u, int wr, int wc, int fr_in, int fq_in) const {
        int fr = fr_in, fq = fq_in; asm volatile("" : "+v"(fr), "+v"(fq));
        const int row0 = u.pm * 256 + wr * 64 + fr, col0 = u.pn * 256 + wc * 32 + 8 * fq;
        const float* bb = bdn + (size_t)u.e * DM;
        f32x4 bv[2][2];
#pragma unroll
        for (int bj = 0; bj < 2; ++bj)
#pragma unroll
            for (int n = 0; n < 2; ++n) bv[bj][n] = *(const f32x4*)(bb + col0 + bj * 128 + 4 * n);
#pragma unroll
        for (int ai = 0; ai < 2; ++ai)
#pragma unroll
            for (int m = 0; m < 4; ++m) {
                const int row = row0 + ai * 128 + m * 16; const float g = rowg[(size_t)u.e * 32768 + u.r0 + (row - u.pm * 256)];
#pragma unroll
                for (int bj = 0; bj < 2; ++bj) {
                    constexpr float dq = 1.0f / (S_ACT * S_WDN);
                    const f32x4 v0 = (acc[ai][bj][m][0] * dq + bv[bj][0]) * g, v1 = (acc[ai][bj][m][1] * dq + bv[bj][1]) * g;
                    u32x2 w; w.x = cvt_fp8x4(v0[0] * S_Y, v0[1] * S_Y, v0[2] * S_Y, v0[3] * S_Y); w.y = cvt_fp8x4(v1[0] * S_Y, v1[1] * S_Y, v1[2] * S_Y, v1[3] * S_Y);
                    *(u32x2*)((unsigned char*)YR + (size_t)row * DM + col0 + bj * 128) = w;
                }
            }
    }
};

namespace att {
constexpr int VS = 192;
constexpr int VIMG = 32 * VS;
DI int crow(int r, int hi) { return (r & 3) + 8 * (r >> 2) + 4 * hi; }
DI float half_swap_other(float x, int hi) { auto rr = __builtin_amdgcn_permlane32_swap(__float_as_uint(x), __float_as_uint(x), false, false); return __uint_as_float(hi ? rr[0] : rr[1]); }
DI f32x2 half_both(float x) { auto rr = __builtin_amdgcn_permlane32_swap(__float_as_uint(x), __float_as_uint(x), false, false); return (f32x2){__uint_as_float(rr[0]), __uint_as_float(rr[1])}; }

struct KV { bf16x8 k[4]; u32x4 v[4]; };
template <bool CLAMP>
DI void kv_load(KV& t, const bf16* Ktile, const bf16* Vb, int pitch, int rbase, int rstride, int rmax, int lane) {
#pragma unroll
    for (int ks = 0; ks < 4; ++ks) t.k[ks] = *(const bf16x8*)(Ktile + ks * 512 + lane * 8);
    if constexpr (CLAMP) {
#pragma unroll
        for (int i = 0; i < 4; ++i) { int r = rbase + (8 * i + (lane >> 3)) * rstride; r = r < 0 ? 0 : (r > rmax ? rmax : r);
            t.v[i] = *(const u32x4*)(Vb + (size_t)r * pitch + 8 * (lane & 7)); }
    } else {
        const char* vt = (const char*)(Vb + (size_t)rbase * pitch);
#pragma unroll
        for (int i = 0; i < 4; ++i) t.v[i] = *(const u32x4*)(vt + (unsigned)(((8 * i + (lane >> 3)) * pitch + 8 * (lane & 7)) * 2));
    }
}
DI void kv_load_rows(KV& t, const bf16* Kb, const bf16* Vb, int pitch, int rbase, int rstride, int rmax, int lane) {
    { int r = rbase + (lane & 31) * rstride; r = r < 0 ? 0 : (r > rmax ? rmax : r);
      const bf16* p = Kb + (size_t)r * pitch + 8 * (lane >> 5);
#pragma unroll
      for (int ks = 0; ks < 4; ++ks) t.k[ks] = *(const bf16x8*)(p + 16 * ks); }
#pragma unroll
    for (int i = 0; i < 4; ++i) { int r = rbase + (8 * i + (lane >> 3)) * rstride; r = r < 0 ? 0 : (r > rmax ? rmax : r);
        t.v[i] = *(const u32x4*)(Vb + (size_t)r * pitch + 8 * (lane & 7)); }
}
DI void k_load(bf16x8 (&k)[4], const bf16* Kb, int pitch, int rbase, int rstride, int rmax, int lane) {
    int r = rbase + (lane & 31) * rstride; r = r < 0 ? 0 : (r > rmax ? rmax : r);
    const bf16* p = Kb + (size_t)r * pitch + 8 * (lane >> 5);
#pragma unroll
    for (int ks = 0; ks < 4; ++ks) k[ks] = *(const bf16x8*)(p + 16 * ks);
}
DI void v_store(LAS unsigned char* vimg, const KV& t, int lane) {
#pragma unroll
    for (int i = 0; i < 4; ++i) *(LAS u32x4*)(vimg + (8 * i + (lane >> 3)) * VS + 16 * (lane & 7)) = t.v[i];
}
DI s16x4 tr_read(const LAS unsigned char* p) { typedef short v4i16_t __attribute__((ext_vector_type(4))); return __builtin_bit_cast(s16x4, __builtin_amdgcn_ds_read_tr16_b64_v4i16((LAS v4i16_t*)p)); }
DI void vt_frags(bf16x8 (&vf)[2][2], const LAS unsigned char* vimg, int lane) {
    const int hi = lane >> 5, blk = (lane >> 4) & 1, q = (lane & 15) >> 2, p = lane & 3;
    const LAS unsigned char* base = vimg + (4 * hi + q) * VS + 2 * (16 * blk + 4 * p);
#pragma unroll
    for (int db = 0; db < 2; ++db)
#pragma unroll
        for (int s = 0; s < 2; ++s) { const s16x4 lo = tr_read(base + (16 * s) * VS + 64 * db), hh = tr_read(base + (16 * s + 8) * VS + 64 * db);
            vf[db][s] = (bf16x8){lo[0], lo[1], lo[2], lo[3], hh[0], hh[1], hh[2], hh[3]}; }
}
DI void q_load(bf16x8 (&q)[4], const bf16* Qrow  , int lane) {
#pragma unroll
    for (int ks = 0; ks < 4; ++ks) q[ks] = *(const bf16x8*)(Qrow + 16 * ks + 8 * (lane >> 5));
}
DI f32x16 zero16() { f32x16 z;
#pragma unroll
    for (int i = 0; i < 16; ++i) z[i] = 0.f; return z; }
DI f32x16 qk(const bf16x8 (&k)[4], const bf16x8 (&q)[4]) {
    f32x16 s = __builtin_amdgcn_mfma_f32_32x32x16_bf16(k[0], q[0], zero16(), 0, 0, 0);
    s = __builtin_amdgcn_mfma_f32_32x32x16_bf16(k[1], q[1], s, 0, 0, 0);
    s = __builtin_amdgcn_mfma_f32_32x32x16_bf16(k[2], q[2], s, 0, 0, 0);
    s = __builtin_amdgcn_mfma_f32_32x32x16_bf16(k[3], q[3], s, 0, 0, 0);
    return s;
}
DI void apply_mask(f32x16& s, int tq, int pbase, int pstride, unsigned W, unsigned DMK, bool sel, int hi) {
#pragma unroll
    for (int r = 0; r < 16; ++r) { const int kp = pbase + crow(r, hi) * pstride; const unsigned dt = (unsigned)(tq - kp);
        const bool ok = sel && dt <= W && (dt & DMK) == 0u && kp >= 0; s[r] = ok ? s[r] : -INFINITY; }
}
DI float max3f_(float a, float b, float c) { return __builtin_fmaxf(__builtin_fmaxf(a, b), c); }
DI float row_max(const f32x16& s) {
    const float m1 = max3f_(s[0], s[1], s[2]), m2 = max3f_(s[3], s[4], s[5]), m3 = max3f_(s[6], s[7], s[8]), m4 = max3f_(s[9], s[10], s[11]), m5 = max3f_(s[12], s[13], s[14]);
    const float a = max3f_(max3f_(m1, m2, m3), max3f_(m4, m5, s[15]), -INFINITY);
    const f32x2 b = half_both(a); return fmaxf(b.x, b.y);
}
struct Head { f32x16 o[2]; float m, l; };
DI void head_init(Head& h) { h.o[0] = zero16(); h.o[1] = zero16(); h.m = -1e30f; h.l = 0.f; }
DI void head_tile(Head& h, f32x16 s, const bf16x8 (&vf)[2][2]) {
    const float mn = fmaxf(h.m, row_max(s));
    const float al = __builtin_amdgcn_exp2f(h.m - mn);
    if (__any(mn > h.m)) {
#pragma unroll
        for (int r = 0; r < 16; ++r) { h.o[0][r] *= al; h.o[1][r] *= al; }
    }
    h.m = mn;
#pragma unroll
    for (int r = 0; r < 16; ++r) s[r] = __builtin_amdgcn_exp2f(s[r] - mn);
    const float sum = (((s[0] + s[1]) + (s[2] + s[3])) + ((s[4] + s[5]) + (s[6] + s[7]))) + (((s[8] + s[9]) + (s[10] + s[11])) + ((s[12] + s[13]) + (s[14] + s[15])));
    h.l = h.l * al + sum;
    u32x4 p0, p1;
    p0.x = cvt_pk(s[0], s[1]); p0.y = cvt_pk(s[2], s[3]); p0.z = cvt_pk(s[4], s[5]); p0.w = cvt_pk(s[6], s[7]);
    p1.x = cvt_pk(s[8], s[9]); p1.y = cvt_pk(s[10], s[11]); p1.z = cvt_pk(s[12], s[13]); p1.w = cvt_pk(s[14], s[15]);
    const bf16x8 pb0 = __builtin_bit_cast(bf16x8, p0), pb1 = __builtin_bit_cast(bf16x8, p1);
#pragma unroll
    for (int db = 0; db < 2; ++db) {
        h.o[db] = __builtin_amdgcn_mfma_f32_32x32x16_bf16(vf[db][0], pb0, h.o[db], 0, 0, 0);
        h.o[db] = __builtin_amdgcn_mfma_f32_32x32x16_bf16(vf[db][1], pb1, h.o[db], 0, 0, 0);
    }
}
DI void head_tile_v(Head& h, f32x16 s, const LAS unsigned char* vimg, int lane) {
    const float mn = fmaxf(h.m, row_max(s));
    const float al = __builtin_amdgcn_exp2f(h.m - mn);
    if (__any(mn > h.m)) {
#pragma unroll
        for (int r = 0; r < 16; ++r) { h.o[0][r] *= al; h.o[1][r] *= al; }
    }
    h.m = mn;
#pragma unroll
    for (int r = 0; r < 16; ++r) s[r] = __builtin_amdgcn_exp2f(s[r] - mn);
    const float sum = (((s[0] + s[1]) + (s[2] + s[3])) + ((s[4] + s[5]) + (s[6] + s[7]))) + (((s[8] + s[9]) + (s[10] + s[11])) + ((s[12] + s[13]) + (s[14] + s[15])));
    h.l = h.l * al + sum;
    u32x4 p0, p1;
    p0.x = cvt_pk(s[0], s[1]); p0.y = cvt_pk(s[2], s[3]); p0.z = cvt_pk(s[4], s[5]); p0.w = cvt_pk(s[6], s[7]);
    p1.x = cvt_pk(s[8], s[9]); p1.y = cvt_pk(s[10], s[11]); p1.z = cvt_pk(s[12], s[13]); p1.w = cvt_pk(s[14], s[15]);
    const bf16x8 pb0 = __builtin_bit_cast(bf16x8, p0), pb1 = __builtin_bit_cast(bf16x8, p1);
    const int hi = lane >> 5, blk = (lane >> 4) & 1, q = (lane & 15) >> 2, p = lane & 3;
    const LAS unsigned char* base = vimg + (4 * hi + q) * VS + 2 * (16 * blk + 4 * p);
#pragma unroll
    for (int db = 0; db < 2; ++db) {
        const s16x4 l0 = tr_read(base + 64 * db), h0 = tr_read(base + 8 * VS + 64 * db), l1 = tr_read(base + 16 * VS + 64 * db), h1 = tr_read(base + 24 * VS + 64 * db);
        const bf16x8 v0 = (bf16x8){l0[0], l0[1], l0[2], l0[3], h0[0], h0[1], h0[2], h0[3]}, v1 = (bf16x8){l1[0], l1[1], l1[2], l1[3], h1[0], h1[1], h1[2], h1[3]};
        h.o[db] = __builtin_amdgcn_mfma_f32_32x32x16_bf16(v0, pb0, h.o[db], 0, 0, 0);
        h.o[db] = __builtin_amdgcn_mfma_f32_32x32x16_bf16(v1, pb1, h.o[db], 0, 0, 0);
    }
}
DI void head_store(const Head& h, unsigned char* orow, float gate, bool accum, int hi) {
    const f32x2 lb = half_both(h.l); const float lt = lb.x + lb.y; const float sc = lt > 0.f ? gate * S_O / lt : 0.f;
#pragma unroll
    for (int db = 0; db < 2; ++db)
#pragma unroll
        for (int g = 0; g < 4; ++g) {
            unsigned char* p = orow + 32 * db + 8 * g + 4 * hi;
            float v0 = h.o[db][4 * g] * sc, v1 = h.o[db][4 * g + 1] * sc, v2 = h.o[db][4 * g + 2] * sc, v3 = h.o[db][4 * g + 3] * sc;
            if (accum) { const int o = *(const int*)p; v0 += __builtin_amdgcn_cvt_f32_fp8(o, 0); v1 += __builtin_amdgcn_cvt_f32_fp8(o, 1); v2 += __builtin_amdgcn_cvt_f32_fp8(o, 2); v3 += __builtin_amdgcn_cvt_f32_fp8(o, 3); }
            *(unsigned*)p = cvt_fp8x4(v0, v1, v2, v3);
        }
}
DI void apply_sel(f32x16& s, bool sel) {
#pragma unroll
    for (int r = 0; r < 16; ++r) s[r] = sel ? s[r] : -INFINITY;
}
template <int NH, bool QLDS, bool CLAMP, bool PERQ = false, class SelF>
DI void run_tiles(Head (&H)[NH], const bf16x8 (&qf)[NH][4], const LAS unsigned char* qimg  , const bf16* Kb  , int ktile0, const bf16* Vb, int pitch, int rmax,
                  int rbase0, int rstride, int pbase0, int pstride, int t0, int t1, int tq, int qmin, int qmax  , unsigned W, unsigned DMK, LAS unsigned char* vimg, int lane, SelF self) {
    const int hi = lane >> 5;
    auto anysel = [&](int tt) -> bool { if constexpr (PERQ) return __any(self(tt, 0) || self(tt, 1)); else return __any(self(tt)); };
    int ta = t0;
    while (ta < t1 && !anysel(ta)) ++ta;
    if (ta >= t1) return;
    auto next_tile = [&](int tc) -> int { int tn = tc + 1; while (tn < t1 && !anysel(tn)) ++tn; return tn; };
    auto load = [&](KV& kv, int tl) { const int tc = tl < t1 ? tl : t1 - 1;
        kv_load<CLAMP>(kv, Kb + (size_t)(ktile0 + tc) * 2048, Vb, pitch, rbase0 + 32 * tc * rstride, rstride, rmax, lane); };
    auto touch = [&](KV& kv) { asm volatile("" :: "v"(kv.k[0]), "v"(kv.k[1]), "v"(kv.k[2]), "v"(kv.k[3]), "v"(kv.v[0]), "v"(kv.v[1]), "v"(kv.v[2]), "v"(kv.v[3])); };
    auto body = [&](const KV& kv, int t) {
        v_store(vimg, kv, lane);
        const int pb = pbase0 + 32 * t * pstride;
        bf16x8 vf[2][2];
        if constexpr (NH == 1) vt_frags(vf, vimg, lane);
#pragma unroll
        for (int h = 0; h < NH; ++h) {
            const int qo = PERQ ? 32 * h : 0;
            bool sel; if constexpr (PERQ) sel = self(t, h); else sel = self(t);
            const bool full = (pb + 31 * pstride > qmin + qo) || ((unsigned)(qmax + qo - pb) > W) || (DMK != 0u) || (pb < 0);
            const bool selall = __all(sel);
            f32x16 s;
            if constexpr (QLDS) { bf16x8 q[4];
#pragma unroll
                for (int ks = 0; ks < 4; ++ks) q[ks] = *(const LAS bf16x8*)(qimg + h * 4096 + ks * 1024 + lane * 16);
                s = qk(kv.k, q); }
            else s = qk(kv.k, qf[h]);
            if (full) apply_mask(s, tq + qo, pb, pstride, W, DMK, sel, hi);
            else if (!selall) apply_sel(s, sel);
            if constexpr (NH == 1) head_tile(H[h], s, vf); else head_tile_v(H[h], s, vimg, lane);
        }
    };
    KV A, B;
    load(A, ta);
    for (;;) {
        int tb = next_tile(ta);
        touch(A); load(B, tb); body(A, ta); if (tb >= t1) break;
        ta = next_tile(tb);
        touch(B); load(A, ta); body(B, tb); if (ta >= t1) break;
    }
    touch(A); touch(B);
}
}

struct AttnCtx {
    const bf16* PROJ; const bf16* KF; const bf16* KM; const bf16* KC; const bf16* VC; const float* GL;
    unsigned char* OA; unsigned char* OB; unsigned char* OC; unsigned* SELM;
};
DI int opaque_v(int x) { asm volatile("" : "+v"(x)); return x; }
DI unsigned wave_pop(unsigned* q, int lane) {
    unsigned v = 0; if (lane == 0) v = __hip_atomic_fetch_add(q, 1u, __ATOMIC_RELAXED, __HIP_MEMORY_SCOPE_AGENT);
    return (unsigned)__builtin_amdgcn_readfirstlane((int)v);
}

DI void moba_unit(const AttnCtx& C, int b, int h, int t0, LAS unsigned char* vimg, int lane_in) {
    using namespace att;
    const int lane = opaque_v(lane_in);
    const int hi = lane >> 5, c = lane & 31, tq = t0 + c, own = t0 >> 8;
    const bf16* base = C.PROJ + (size_t)b * SEQ * PP;
    bf16x8 qf[2][4]; unsigned selm[2];
#pragma unroll
    for (int p = 0; p < 2; ++p) {
        q_load(qf[p], base + (size_t)(tq + 32 * p) * PP + C_AQ + h * 64, lane);
        selm[p] = 0u;
        if (own > 0) {
            bf16x8 kmf[4]; k_load(kmf, C.KM + (size_t)(b * 4 + h) * 32 * 64, 64, 0, 1, 31, lane);
            const f32x16 g = qk(kmf, qf[p]);
            float ga[16];
#pragma unroll
            for (int r = 0; r < 8; ++r) { const f32x2 bb = half_both(g[r]); ga[crow(r, 0)] = bb.x; ga[crow(r, 0) + 4] = bb.y; }
#pragma unroll
            for (int it = 0; it < 3; ++it) {
                float best = -INFINITY; int bi = -1;
#pragma unroll
                for (int j = 0; j < 16; ++j) { const bool ok = (j < own) && !((selm[p] >> j) & 1u) && (ga[j] > best); best = ok ? ga[j] : best; bi = ok ? j : bi; }
                if (bi >= 0) selm[p] |= 1u << bi;
            }
        }
    }
    Head H[2]; head_init(H[0]); head_init(H[1]);
    const bf16* Kb = C.KF + (size_t)((b * 14 + h) * 128) * 2048; const bf16* Vb = base + C_AV + h * 64;
    const int tl = ((t0 + 32) >> 5) + 1;
    const unsigned s0 = selm[0], s1 = selm[1];
    auto self = [&](int t, int p) -> bool { const int j = t >> 3; return (j >= own) || (((p ? s1 : s0) >> j) & 1u); };
    LAS unsigned char* qimg = vimg + VIMG;
#pragma unroll
    for (int p = 0; p < 2; ++p)
#pragma unroll
        for (int ks = 0; ks < 4; ++ks) *(LAS bf16x8*)(qimg + p * 4096 + ks * 1024 + lane * 16) = qf[p][ks];
    run_tiles<2, true, false, true>(H, qf, qimg, Kb, 0, Vb, PP, SEQ - 1, 0, 1, 0, 1, 0, tl, tq, t0, t0 + 31, 0x7fffffffu, 0u, vimg, lane, self);
    head_store(H[0], C.OA + (size_t)(b * SEQ + tq) * 1024 + h * 64, 1.0f, false, hi);
    head_store(H[1], C.OA + (size_t)(b * SEQ + tq + 32) * 1024 + h * 64, 1.0f, false, hi);
}

DI void nsa_cmp(const AttnCtx& C, int b, int g, int t0, LAS unsigned char* vimg, int lane_in) {
    using namespace att;
    const int lane = opaque_v(lane_in);
    const int hi = lane >> 5, c = lane & 31, tq = t0 + c, own = t0 >> 6;
    const bf16* base = C.PROJ + (size_t)b * SEQ * PP;
    const float* gl = C.GL + (size_t)(b * SEQ + tq) * NGATE + g * 9;
    unsigned char* orow = C.OB + (size_t)(b * SEQ + tq) * 1024 + g * 192;
    const bf16* Kc = C.KC + (size_t)(b * 2 + g) * 256 * 64; const bf16* Vc = C.VC + (size_t)(b * 2 + g) * 256 * 64;
    LAS float* impl = (LAS float*)(vimg + VIMG) + lane;
    const int ncv = (t0 >> 4) + 1;
    const int nct = ncv > 255 ? 8 : (ncv + 31) >> 5;
    float mx[3], il[3];
    {
        bf16x8 qf[3][4];
#pragma unroll
        for (int r = 0; r < 3; ++r) q_load(qf[r], base + (size_t)tq * PP + C_BQ + (g * 3 + r) * 64, lane);
        float ls[3];
#pragma unroll
        for (int r = 0; r < 3; ++r) { mx[r] = -1e30f; ls[r] = 0.f; }
#pragma nounroll
        for (int t = 0; t < nct; ++t) {
            bf16x8 kf[4]; k_load(kf, Kc, 64, 32 * t, 1, 255, lane);
#pragma unroll
            for (int r = 0; r < 3; ++r) {
                f32x16 s = qk(kf, qf[r]);
                apply_mask(s, tq, 16 * 32 * t + 31, 16, 0x7fffffffu, 0u, true, hi);
                const float mn = fmaxf(mx[r], row_max(s)); float sum = 0.f;
#pragma unroll
                for (int i = 0; i < 16; ++i) sum += __builtin_amdgcn_exp2f(s[i] - mn);
                ls[r] = ls[r] * __builtin_amdgcn_exp2f(mx[r] - mn) + sum; mx[r] = mn;
            }
        }
#pragma unroll
        for (int r = 0; r < 3; ++r) { const f32x2 lb = half_both(ls[r]); const float lt = lb.x + lb.y; il[r] = lt > 0.f ? 1.0f / lt : 0.f; }
    }
#pragma unroll
    for (int i = 0; i < 32; ++i) impl[i * 64] = 0.f;
#pragma unroll
    for (int r = 0; r < 3; ++r) {
        Head H; head_init(H);
        bf16x8 qb[4]; q_load(qb, base + (size_t)tq * PP + C_BQ + (g * 3 + r) * 64, lane);
        float carry = 0.f;
#pragma nounroll
        for (int t = 0; t < nct; ++t) {
            KV kv; kv_load_rows(kv, Kc, Vc, 64, 32 * t, 1, 255, lane);
            v_store(vimg, kv, lane);
            bf16x8 vf[2][2]; vt_frags(vf, vimg, lane);
            f32x16 s = qk(kv.k, qb);
            apply_mask(s, tq, 16 * 32 * t + 31, 16, 0x7fffffffu, 0u, true, hi);
#pragma unroll
            for (int i = 0; i < 16; ++i) s[i] = __builtin_amdgcn_exp2f(s[i] - mx[r]) * il[r];
            u32x4 p0, p1;
            p0.x = cvt_pk(s[0], s[1]); p0.y = cvt_pk(s[2], s[3]); p0.z = cvt_pk(s[4], s[5]); p0.w = cvt_pk(s[6], s[7]);
            p1.x = cvt_pk(s[8], s[9]); p1.y = cvt_pk(s[10], s[11]); p1.z = cvt_pk(s[12], s[13]); p1.w = cvt_pk(s[14], s[15]);
            const bf16x8 pb0 = __builtin_bit_cast(bf16x8, p0), pb1 = __builtin_bit_cast(bf16x8, p1);
#pragma unroll
            for (int db = 0; db < 2; ++db) {
                H.o[db] = __builtin_amdgcn_mfma_f32_32x32x16_bf16(vf[db][0], pb0, H.o[db], 0, 0, 0);
                H.o[db] = __builtin_amdgcn_mfma_f32_32x32x16_bf16(vf[db][1], pb1, H.o[db], 0, 0, 0);
            }
            float a[4], bq[4];
#pragma unroll
            for (int gq = 0; gq < 4; ++gq) { const f32x2 bb = half_both(s[4 * gq + 3]); a[gq] = bb.x; bq[gq] = bb.y; }
#pragma unroll
            for (int gq = 0; gq < 4; ++gq) {
                const float ext = hi ? a[gq] : (gq == 0 ? carry : bq[gq - 1]);
                impl[(4 * t + gq) * 64] += (s[4 * gq] + s[4 * gq + 1]) + (s[4 * gq + 2] + s[4 * gq + 3]) + ext;
            }
            carry = bq[3];
        }
        H.l = 0.5f;
        head_store(H, orow + r * 64, sigmoidf_(gl[r * 3 + 0]), false, hi);
    }
    unsigned m0, m1;
    if (own < 16) {
        const unsigned ne = (own >> 1) + 1, no = (own + 1) >> 1;
        m0 = ne >= 32 ? 0xffffffffu : ((1u << ne) - 1u); m1 = no >= 32 ? 0xffffffffu : ((1u << no) - 1u);
    } else {
        unsigned mine = 0u;
#pragma unroll 4
        for (int i = 0; i < 32; ++i) { const int mblk = 2 * i + hi; const bool forced = (mblk == 0) || (mblk == own) || (mblk == own - 1);
            const float v = impl[i * 64]; impl[i * 64] = mblk > own ? -INFINITY : (forced ? 1e6f : v); }
#pragma nounroll
        for (int it = 0; it < 16; ++it) {
            float best = -INFINITY; int bi = 0;
#pragma unroll 8
            for (int i = 0; i < 32; ++i) { const float v = impl[i * 64]; const bool ok = v > best; best = ok ? v : best; bi = ok ? i : bi; }
            const f32x2 bv = half_both(best); const f32x2 bx = half_both(__int_as_float(2 * bi + hi));
            const int i0 = __float_as_int(bx.x), i1 = __float_as_int(bx.y);
            const bool win0 = (bv.x > bv.y) || (bv.x == bv.y && i0 < i1);
            const bool me = hi ? !win0 : win0;
            const float wv = win0 ? bv.x : bv.y;
            if (me && wv > -INFINITY) { mine |= 1u << bi; impl[bi * 64] = -INFINITY; }
        }
        auto rr = __builtin_amdgcn_permlane32_swap(mine, mine, false, false); m0 = rr[0]; m1 = rr[1];
    }
    if (hi == 0) *(u32x2*)(C.SELM + ((size_t)(b * 2 + g) * SEQ + tq) * 2) = (u32x2){m0, m1};
}
DI void nsa_rest(const AttnCtx& C, int b, int g, int t0, int part, LAS unsigned char* vimg, int lane_in) {
    using namespace att;
    const int lane = opaque_v(lane_in);
    const int hi = lane >> 5, c = lane & 31, tq = t0 + c;
    const bf16* base = C.PROJ + (size_t)b * SEQ * PP;
    const float* gl = C.GL + (size_t)(b * SEQ + tq) * NGATE + g * 9;
    unsigned char* orow = C.OB + (size_t)(b * SEQ + tq) * 1024 + g * 192;
    const u32x2 mm_ = *(const u32x2*)(C.SELM + ((size_t)(b * 2 + g) * SEQ + tq) * 2); const unsigned m0 = mm_.x, m1 = mm_.y;
    {
        auto self = [&](int t) -> bool { const int mb = t >> 1; const unsigned w = (mb & 1) ? m1 : m0; return (w >> (mb >> 1)) & 1u; };
        auto allf = [&](int) -> bool { return true; };
        const int tl = (t0 >> 5) + 1, tf = (t0 - 511) < 0 ? 0 : ((t0 - 511) >> 5);
        const bf16* Ks = C.KF + (size_t)((b * 14 + 4 + g) * 128) * 2048; const bf16* Vs = base + C_BVS + g * 64; const bf16* Kw = C.KF + (size_t)((b * 14 + 6 + g) * 128) * 2048; const bf16* Vw = base + C_BVW + g * 64;
        LAS unsigned char* qimg = vimg + VIMG;
        if (part == 0) {
            bf16x8 q2[2][4];
#pragma unroll
            for (int r = 0; r < 2; ++r) { q_load(q2[r], base + (size_t)tq * PP + C_BQ + (g * 3 + r) * 64, lane);
#pragma unroll
                for (int ks = 0; ks < 4; ++ks) *(LAS bf16x8*)(qimg + r * 4096 + ks * 1024 + lane * 16) = q2[r][ks]; }
            { Head H[2]; head_init(H[0]); head_init(H[1]);
              run_tiles<2, true, false>(H, q2, qimg, Ks, 0, Vs, PP, SEQ - 1, 0, 1, 0, 1, 0, tl, tq, t0, t0 + 31, 0x7fffffffu, 0u, vimg, lane, self);
              head_store(H[0], orow, sigmoidf_(gl[1]), true, hi); head_store(H[1], orow + 64, sigmoidf_(gl[4]), true, hi); }
            { Head H[2]; head_init(H[0]); head_init(H[1]);
              run_tiles<2, true, false>(H, q2, qimg, Kw, 0, Vw, PP, SEQ - 1, 0, 1, 0, 1, tf, tl, tq, t0, t0 + 31, 511u, 0u, vimg, lane, allf);
              head_store(H[0], orow, sigmoidf_(gl[2]), true, hi); head_store(H[1], orow + 64, sigmoidf_(gl[5]), true, hi); }
        }
        if (part == 1) {
            bf16x8 q1[1][4]; q_load(q1[0], base + (size_t)tq * PP + C_BQ + (g * 3 + 2) * 64, lane);
            { Head H[1]; head_init(H[0]);
              run_tiles<1, false, false>(H, q1, nullptr, Ks, 0, Vs, PP, SEQ - 1, 0, 1, 0, 1, 0, tl, tq, t0, t0 + 31, 0x7fffffffu, 0u, vimg, lane, self);
              head_store(H[0], orow + 128, sigmoidf_(gl[7]), true, hi); }
            { Head H[1]; head_init(H[0]);
              run_tiles<1, false, false>(H, q1, nullptr, Kw, 0, Vw, PP, SEQ - 1, 0, 1, 0, 1, tf, tl, tq, t0, t0 + 31, 511u, 0u, vimg, lane, allf);
              head_store(H[0], orow + 128, sigmoidf_(gl[8]), true, hi); }
        }
    }
}
DI void dil_unit(const AttnCtx& C, int b, int hh, int rho, int lt, LAS unsigned char* vimg, int lane_in) {
    using namespace att;
    const int lane = opaque_v(lane_in);
    const int hi = lane >> 5, c = lane & 31;
    const int qmin = rho + 512 * lt, qmax = qmin + 496, tq = qmin + 16 * c;
    const bf16* base = C.PROJ + (size_t)b * SEQ * PP;
    Head H[1]; head_init(H[0]);
    auto self = [&](int) -> bool { return true; };
#pragma unroll
    for (int gi = 0; gi < 3; ++gi) {
        const int head = 2 * gi + hh; const int w = gi == 0 ? 128 : (gi == 1 ? 512 : 2048); const int st = gi == 0 ? 1 : (gi == 1 ? 4 : 16);
        bf16x8 qf[1][4]; q_load(qf[0], base + (size_t)tq * PP + C_CQ + head * 64, lane);
        const int sl = gi == 0 ? 0 : (gi == 1 ? 2 : 4), cls = rho & (st - 1);
        const int m0 = (512 * lt - w) >> sl;
        const int kb = cls + st * m0;
        const int nt = gi == 0 ? 20 : (gi == 1 ? 8 : 5);
        const int tf = m0 < 0 ? ((-m0) >> 5) : 0;
        const bf16* Kh = C.KF + (size_t)((b * 14 + 8 + head) * 128) * 2048;
        run_tiles<1, false, true>(H, qf, nullptr, Kh, cls * (128 >> sl) + (m0 >> 5), base + C_CV + head * 64, PP, SEQ - 1, kb, st, kb, st, tf, nt, tq, qmin, qmax, (unsigned)w, 0u, vimg, lane, self);
    }
    unsigned char* orow = C.OC + (size_t)(b * SEQ + tq) * 1024;
    head_store(H[0], orow + hh * 64, 1.0f, false, hi);
    if (hh == 0) {
#pragma unroll
        for (int i = 0; i < 4; ++i) { *(u32x4*)(orow + 128 + 16 * (i * 2 + hi)) = (u32x4){0u, 0u, 0u, 0u}; *(u32x4*)(orow + 640 + 16 * (i * 2 + hi)) = (u32x4){0u, 0u, 0u, 0u}; }
    }
}

DI void prep_km(const bf16* KF, bf16* KM, int item, int lane) {
    const int b = item >> 6, h = (item >> 4) & 3, blk = item & 15;
    const bf16* src = KF + ((size_t)((b * 14 + h) * 128 + 8 * blk)) * 2048 + (lane & 7) * 256 + (lane >> 3) * 8;
    float acc[8];
#pragma unroll
    for (int j = 0; j < 8; ++j) acc[j] = 0.f;
#pragma unroll 4
    for (int i = 0; i < 32; ++i) { const u32x4 w = *(const u32x4*)(src + (size_t)(i >> 2) * 2048 + (i & 3) * 64);
        acc[0] += bf_lo(w.x); acc[1] += bf_hi(w.x); acc[2] += bf_lo(w.y); acc[3] += bf_hi(w.y); acc[4] += bf_lo(w.z); acc[5] += bf_hi(w.z); acc[6] += bf_lo(w.w); acc[7] += bf_hi(w.w); }
#pragma unroll
    for (int j = 0; j < 8; ++j) { acc[j] += __shfl_xor(acc[j], 8); acc[j] += __shfl_xor(acc[j], 16); acc[j] += __shfl_xor(acc[j], 32); acc[j] *= (1.0f / 256.0f); }
    bf16* dst = KM + (size_t)((b * 4 + h) * 32) * 64;
    if (lane < 8) { u32x4 w; w.x = cvt_pk(acc[0], acc[1]); w.y = cvt_pk(acc[2], acc[3]); w.z = cvt_pk(acc[4], acc[5]); w.w = cvt_pk(acc[6], acc[7]); *(u32x4*)(dst + blk * 64 + 8 * lane) = w; }
    if (blk == 0) { *(u32x4*)(dst + 16 * 64 + 8 * lane) = (u32x4){0u, 0u, 0u, 0u}; *(u32x4*)(dst + 24 * 64 + 8 * lane) = (u32x4){0u, 0u, 0u, 0u}; }
}
DI void cmp_unit_wg(const bf16* PROJ, const bf16* W1T, const bf16* W2T, const float* b1p, bf16* OUT, int b, int g, int col0, int nt, LAS float* red, int wave, int lane) {
    using namespace att;
    const int hi = lane >> 5, c = lane & 31, kq = wave & 3, nh = wave >> 2;
    const int n = nt * 32 + c, ne = n > 254 ? 254 : n;
    const bf16* inb = PROJ + (size_t)(b * SEQ + 16 * ne) * PP + col0 + 8 * hi;
    const bf16* wa = W1T + (size_t)(64 * nh + c) * 2048 + 8 * hi;
    f32x16 acc[2]; acc[0] = zero16(); acc[1] = zero16();
#pragma unroll 4
    for (int kk = kq * 32; kk < kq * 32 + 32; ++kk) {
        const bf16x8 bf = *(const bf16x8*)(inb + (size_t)(kk >> 2) * PP + 16 * (kk & 3));
#pragma unroll
        for (int jb = 0; jb < 2; ++jb) { const bf16x8 af = *(const bf16x8*)(wa + (size_t)(32 * jb) * 2048 + 16 * kk); acc[jb] = __builtin_amdgcn_mfma_f32_32x32x16_bf16(af, bf, acc[jb], 0, 0, 0); }
    }
#pragma unroll
    for (int jb = 0; jb < 2; ++jb)
#pragma unroll
        for (int r = 0; r < 16; ++r) red[(((2 * nh + jb) * 4 + kq) * 16 + r) * 64 + lane] = acc[jb][r];
    __syncthreads();
    LAS float* red2 = red + 16384;
    if (wave < 4) {
        const int jb = wave; float hv[16];
#pragma unroll
        for (int r = 0; r < 16; ++r) { const LAS float* pp = red + ((jb * 4) * 16 + r) * 64 + lane; const float v4 = (pp[0] + pp[16 * 64]) + (pp[2 * 16 * 64] + pp[3 * 16 * 64]);
            const int j = 32 * jb + crow(r, hi); const float v = v4 + ((b1p[j] + b1p[128 + j]) + (b1p[256 + j] + b1p[384 + j])); hv[r] = v * sigmoidf_(v); }
        f32x16 o2[2]; o2[0] = zero16(); o2[1] = zero16();
#pragma unroll
        for (int s = 0; s < 2; ++s) {
            u32x4 p; p.x = cvt_pk(hv[8 * s], hv[8 * s + 1]); p.y = cvt_pk(hv[8 * s + 2], hv[8 * s + 3]); p.z = cvt_pk(hv[8 * s + 4], hv[8 * s + 5]); p.w = cvt_pk(hv[8 * s + 6], hv[8 * s + 7]);
            const bf16x8 pb = __builtin_bit_cast(bf16x8, p);
#pragma unroll
            for (int db = 0; db < 2; ++db) {
                const bf16* wp = W2T + (size_t)(32 * db + c) * 128 + 32 * jb + 16 * s + 4 * hi;
                const u32x2 lo = *(const u32x2*)wp, hh = *(const u32x2*)(wp + 8);
                const u32x4 a4 = {lo.x, lo.y, hh.x, hh.y};
                o2[db] = __builtin_amdgcn_mfma_f32_32x32x16_bf16(__builtin_bit_cast(bf16x8, a4), pb, o2[db], 0, 0, 0);
            }
        }
#pragma unroll
        for (int db = 0; db < 2; ++db)
#pragma unroll
            for (int r = 0; r < 16; ++r) red2[((jb * 2 + db) * 16 + r) * 64 + lane] = o2[db][r];
    }
    __syncthreads();
    if (wave == 0) {
        bf16* orow = OUT + (size_t)((b * 2 + g) * 256 + n) * 64;
#pragma unroll
        for (int db = 0; db < 2; ++db)
#pragma unroll
            for (int gq = 0; gq < 4; ++gq) { float v[4];
#pragma unroll
                for (int i = 0; i < 4; ++i) { const LAS float* pp = red2 + (db * 16 + 4 * gq + i) * 64 + lane; v[i] = (pp[0] + pp[2 * 16 * 64]) + (pp[4 * 16 * 64] + pp[6 * 16 * 64]); }
                u32x2 w; w.x = cvt_pk(v[0], v[1]); w.y = cvt_pk(v[2], v[3]); *(u32x2*)(orow + 32 * db + 8 * gq + 4 * hi) = w; }
    }
    __syncthreads();
}

struct Row { f32x4 v[4]; };
DI void row_load(Row& r, const float* p, int lane) {
#pragma unroll
    for (int j = 0; j < 4; ++j) r.v[j] = *(const f32x4*)(p + 256 * j + 4 * lane);
}
DI void row_store(const Row& r, float* p, int lane) {
#pragma unroll
    for (int j = 0; j < 4; ++j) *(f32x4*)(p + 256 * j + 4 * lane) = r.v[j];
}
DI void row_store_bf16(const Row& r, bf16* p, int lane) {
#pragma unroll
    for (int j = 0; j < 4; ++j) { u32x2 w; w.x = cvt_pk(r.v[j][0], r.v[j][1]); w.y = cvt_pk(r.v[j][2], r.v[j][3]); *(u32x2*)(p + 256 * j + 4 * lane) = w; }
}
DI void row_store_fp8(const Row& r, unsigned char* p, float sc, int lane) {
#pragma unroll
    for (int j = 0; j < 4; ++j) *(unsigned*)(p + 256 * j + 4 * lane) = cvt_fp8x4(r.v[j][0] * sc, r.v[j][1] * sc, r.v[j][2] * sc, r.v[j][3] * sc);
}
DI void row_ln(Row& r) {
    float s = 0.f;
#pragma unroll
    for (int j = 0; j < 4; ++j) s += (r.v[j][0] + r.v[j][1]) + (r.v[j][2] + r.v[j][3]);
    const float mean = wave_sum(s) * (1.0f / DM); float q = 0.f;
#pragma unroll
    for (int j = 0; j < 4; ++j) { r.v[j] = r.v[j] - mean; q += (r.v[j][0] * r.v[j][0] + r.v[j][1] * r.v[j][1]) + (r.v[j][2] * r.v[j][2] + r.v[j][3] * r.v[j][3]); }
    const float rstd = 1.0f / sqrtf(wave_sum(q) * (1.0f / DM) + LN_EPS);
#pragma unroll
    for (int j = 0; j < 4; ++j) r.v[j] = r.v[j] * rstd;
}
DI void row_affine(Row& r, const float* scale, const float* shift, float one, int lane) {
#pragma unroll
    for (int j = 0; j < 4; ++j) { const f32x4 a = *(const f32x4*)(scale + 256 * j + 4 * lane), bq = *(const f32x4*)(shift + 256 * j + 4 * lane); r.v[j] = r.v[j] * (a + one) + bq; }
}
DI float row_dot(const Row& r, const f32x4 (&w)[4]) {
    f32x4 a = r.v[0] * w[0];
#pragma unroll
    for (int j = 1; j < 4; ++j) a += r.v[j] * w[j];
    return (a[0] + a[1]) + (a[2] + a[3]); }
DI void wvec_lds(f32x4 (&w)[4], const LAS float* p) {
#pragma unroll
    for (int j = 0; j < 4; ++j) w[j] = *(const LAS f32x4*)(p + 256 * j);
}
#define WVEC_TOUCH(w) asm volatile("" :: "v"((w)[0]), "v"((w)[1]), "v"((w)[2]), "v"((w)[3]))
struct Vec { f32x4 v[4]; };
DI void vec_load(Vec& p, const float* src, int lane) {
#pragma unroll
    for (int j = 0; j < 4; ++j) p.v[j] = *(const f32x4*)(src + 256 * j + 4 * lane);
}
DI void row_affine_r(Row& r, const Vec& scale, const Vec& shift, float one) {
#pragma unroll
    for (int j = 0; j < 4; ++j) r.v[j] = r.v[j] * (scale.v[j] + one) + shift.v[j];
}
DI void row_affine_l(Row& r, const LAS float* scale, const LAS float* shift, float one, int lane) {
#pragma unroll
    for (int j = 0; j < 4; ++j) { const f32x4 a = *(const LAS f32x4*)(scale + 256 * j + 4 * lane), bq = *(const LAS f32x4*)(shift + 256 * j + 4 * lane); r.v[j] = r.v[j] * (a + one) + bq; }
}
DI void ln1_tail(Row& r, const LAS float* wg, bf16* hrow, unsigned char* h8row, float* glrow, int lane);
DI void ln1_row(Row& r  , const float* modb  , const LAS float* wg, bf16* hrow, unsigned char* h8row, float* glrow, int lane) {
    row_ln(r); row_affine(r, modb + DM, modb, 1.0f, lane);
    ln1_tail(r, wg, hrow, h8row, glrow, lane);
}
DI void ln1_tail(Row& r  , const LAS float* wg, bf16* hrow, unsigned char* h8row, float* glrow, int lane) {
    (void)hrow; row_store_fp8(r, h8row, S_H, lane);
    float gv[16], g16 = 0.f, g17 = 0.f;
    { f32x4 wa[4], wb[4]; const LAS float* wp = wg + 4 * lane; wvec_lds(wa, wp);
#pragma unroll
      for (int o = 0; o < NGATE; o += 2) {
          wvec_lds(wb, wp + (o + 1) * DM); asm volatile("" ::: "memory"); WVEC_TOUCH(wa);
          { const float s = row_dot(r, wa); if (o < 16) gv[o] = s; else g16 = s; }
          if (o + 2 < NGATE) wvec_lds(wa, wp + (o + 2) * DM);
          asm volatile("" ::: "memory"); WVEC_TOUCH(wb);
          { const float s = row_dot(r, wb); if (o + 1 < 16) gv[o + 1] = s; else g17 = s; } } }
    const float m16 = reduce_scatter16(gv, lane); g16 = wave_sum(g16); g17 = wave_sum(g17);
    if (lane < NGATE) glrow[lane] = lane < 16 ? m16 : (lane == 16 ? g16 : g17);
}
DI void lds_fill(LAS float* dst, const float* src, int nfloats, int tid) {
    for (int i = tid * 4; i < nfloats; i += 512 * 4) *(LAS f32x4*)(dst + i) = *(const f32x4*)(src + i);
}
DI int win_src(int n) {
    if (n < 2048) {
        int bm, bo;
        if (n < 256) { bm = C_AQ; bo = O_AQ; } else if (n < 512) { bm = C_AK; bo = O_AK; } else if (n < 896) { bm = C_BQ; bo = O_BQ; } else if (n < 1024) { bm = C_BKC; bo = O_BKC; }
        else if (n < 1152) { bm = C_BKS; bo = O_BKS; } else if (n < 1280) { bm = C_BKW; bo = O_BKW; } else if (n < 1664) { bm = C_CQ; bo = O_CQ; } else { bm = C_CK; bo = O_CK; }
        const int r = n - bm, cc = r & 63; return bo + (r & ~63) + (cc >> 1) + 32 * (cc & 1);
    }
    if (n < 2304) return O_AV + (n - C_AV);
    if (n < 2432) return O_BVC + (n - C_BVC);
    if (n < 2560) return O_BVS + (n - C_BVS);
    if (n < 2688) return O_BVW + (n - C_BVW);
    if (n < 3072) return O_CV + (n - C_CV);
    return O_MG + (n - C_MG);
}
DI int ileave(int c) { return (c & ~63) + ((c & 63) >> 1) + 32 * (c & 1); }
template <int KMODE, int NMODE>
DI void transpose_item(const float* W, int ldw, bf16* WT, int ldt, int k0, int n0, LAS float* scr, int lane) {
    const int nn = n0 + (lane & 31); const int ns = NMODE == 0 ? nn : (NMODE == 1 ? ileave(nn) : win_src(nn));
#pragma unroll 8
    for (int i = 0; i < 32; ++i) { const int kk = 2 * i + (lane >> 5); const int k = k0 + kk; const int ks = KMODE == 0 ? k : ileave(k); scr[kk * 33 + (lane & 31)] = W[(size_t)ks * ldw + ns]; }
    LDS_WAIT(); asm volatile("" ::: "memory");
    const int c = lane & 7;
#pragma unroll
    for (int j = 0; j < 4; ++j) { const int n = (lane >> 3) + 8 * j; const LAS float* s = scr + (8 * c) * 33 + n;
        u32x4 o; o.x = cvt_pk(s[0 * 33], s[1 * 33]); o.y = cvt_pk(s[2 * 33], s[3 * 33]); o.z = cvt_pk(s[4 * 33], s[5 * 33]); o.w = cvt_pk(s[6 * 33], s[7 * 33]);
        *(u32x4*)(WT + (size_t)(n0 + n) * ldt + k0 + 8 * c) = o; }
    LDS_WAIT(); asm volatile("" ::: "memory");
}

template <int NMODE = 0, int NOFF = 0>
DI void transpose_item_fp8(const float* W, int ldw, unsigned char* WT, int ldt, int k0, int n0, float sc, LAS float* scr, int lane) {
    const int nn = NMODE == 2 ? win_src(NOFF + n0 + (lane & 31)) : n0 + (lane & 31);
    float stg[32];
#pragma unroll
    for (int i = 0; i < 32; ++i) { const int kk = 2 * i + (lane >> 5); stg[i] = W[(size_t)(k0 + kk) * ldw + nn]; }
    asm volatile("" ::: "memory");
#pragma unroll
    for (int i = 0; i < 32; ++i) { const int kk = 2 * i + (lane >> 5); scr[kk * 33 + (lane & 31)] = stg[i]; }
    LDS_WAIT(); asm volatile("" ::: "memory");
    const int c = lane & 7;
#pragma unroll
    for (int j = 0; j < 4; ++j) { const int n = (lane >> 3) + 8 * j; const LAS float* s = scr + (8 * c) * 33 + n;
        u32x2 o; o.x = cvt_fp8x4(s[0 * 33] * sc, s[1 * 33] * sc, s[2 * 33] * sc, s[3 * 33] * sc); o.y = cvt_fp8x4(s[4 * 33] * sc, s[5 * 33] * sc, s[6 * 33] * sc, s[7 * 33] * sc);
        *(u32x2*)(WT + (size_t)(n0 + n) * ldt + k0 + 8 * c) = o; }
    LDS_WAIT(); asm volatile("" ::: "memory");
}

struct Args {
    const float* x; const float* c; const int* pos; const float* w_ada; const float* b_ada; const float* w_in;
    const float* w1k; const float* w2k; const float* pek; const float* w1v; const float* w2v; const float* pev;
    const float* wba; const float* wbb; const float* wbc; const float* wout; const float* ln1g; const float* ln1b;
    const float* rw; const float* rb; const float* wgu; const float* bgu; const float* wdn; const float* bdn; const float* ln2g; const float* ln2b;
    float* out; unsigned char* ws; int ph_lo, ph_hi, use_bar, qsel, amask, pad;
};
constexpr int NPH = 1 + 12 * DEPTH;

constexpr int I_IN = 16 * 192, I_BA = 4 * 32, I_BB = 6 * 32, I_BC = 2 * 32, I_BCZ = 64, I_OUT = 16 * 32, I_W1 = 32 * 4, I_W2 = 2 * 2, I_GU = 16 * 64 * NEXP, I_DN = 16 * 32 * NEXP;
constexpr int I_SM = I_IN + I_BA + I_BB + I_BC + I_BCZ + I_OUT + 2 * I_W1 + 2 * I_W2, I_L = I_SM + I_GU + I_DN;
constexpr int CW_CV = 16384;
static_assert(I_SM % 8 == 0 && (I_GU + I_DN) % 16 == 0, "conversion items are popped 8 / 16 at a time");
constexpr int CV_DEPTH = 4, CV_POP = 16, CV_WAVES = 1;
struct CvDesc { const float* rowb; unsigned char* dst; int ldw; float sc; };
DI CvDesc cv_desc(const Args& args, unsigned char* ws, int l, int j) {
    unsigned char* wl = ws + WS_WL + (size_t)l * WL_STRIDE; CvDesc d;
    if (j < I_GU) { const int e = j / 1024, q = j % 1024, k0 = 64 * (q / 64), n0 = 32 * (q % 64);
        d.rowb = args.wgu + ((size_t)l * NEXP + e) * DM * 2048 + (size_t)k0 * 2048 + n0; d.dst = wl + WL_GU + (size_t)e * 2048 * DM + (size_t)n0 * DM + k0; d.ldw = 2048; d.sc = S_WGU; }
    else { j -= I_GU; const int e = j / 512, q = j % 512, k0 = 64 * (q / 32), n0 = 32 * (q % 32);
        d.rowb = args.wdn + ((size_t)l * NEXP + e) * DM * DM + (size_t)k0 * DM + n0; d.dst = wl + WL_DN + (size_t)e * DM * DM + (size_t)n0 * DM + k0; d.ldw = DM; d.sc = S_WDN; }
    return d;
}
DI void cv_ld(float (&stg)[32], const CvDesc& d, int lane) {
    const int lo = (lane >> 5) * 32 * d.ldw + (lane & 31);
#pragma unroll
    for (int i = 0; i < 32; ++i) stg[i] = (d.rowb + (size_t)i * d.ldw)[lo];
}
DI void cv_st(const float (&stg)[32], const CvDesc& d, int lane) {
    const float sc = d.sc; u32x4 o0, o1;
    o0.x = cvt_fp8x4(stg[0] * sc, stg[1] * sc, stg[2] * sc, stg[3] * sc);     o0.y = cvt_fp8x4(stg[4] * sc, stg[5] * sc, stg[6] * sc, stg[7] * sc);
    o0.z = cvt_fp8x4(stg[8] * sc, stg[9] * sc, stg[10] * sc, stg[11] * sc);   o0.w = cvt_fp8x4(stg[12] * sc, stg[13] * sc, stg[14] * sc, stg[15] * sc);
    o1.x = cvt_fp8x4(stg[16] * sc, stg[17] * sc, stg[18] * sc, stg[19] * sc); o1.y = cvt_fp8x4(stg[20] * sc, stg[21] * sc, stg[22] * sc, stg[23] * sc);
    o1.z = cvt_fp8x4(stg[24] * sc, stg[25] * sc, stg[26] * sc, stg[27] * sc); o1.w = cvt_fp8x4(stg[28] * sc, stg[29] * sc, stg[30] * sc, stg[31] * sc);
    unsigned char* p = d.dst + (size_t)(lane & 31) * DM + (lane >> 5) * 32;
    *(u32x4*)p = o0; *(u32x4*)(p + 16) = o1;
}
DI void cv_item(const Args& args, unsigned char* ws, int l, int r, LAS float* scr, int lane) {
    unsigned char* wl = ws + WS_WL + (size_t)l * WL_STRIDE;
    if (r < I_IN) { const int n0 = 32 * (r % 192);
        transpose_item_fp8<2, 0>(args.w_in + (size_t)l * DM * IN_W, IN_W, wl + WL_IN, DM, 64 * (r / 192), n0, S_WIN, scr, lane);
        return; } r -= I_IN;
    if (r < I_BA) { transpose_item_fp8(args.wba + (size_t)l * 256 * DM, DM, wl + WL_BA, DM, 64 * (r / 32), 32 * (r % 32), S_WB, scr, lane); return; } r -= I_BA;
    if (r < I_BB) { transpose_item_fp8(args.wbb + (size_t)l * 384 * DM, DM, wl + WL_BA + 512, DM, 64 * (r / 32), 32 * (r % 32), S_WB, scr, lane); return; } r -= I_BB;
    if (r < I_BC) { transpose_item_fp8(args.wbc + (size_t)l * 128 * DM, DM, wl + WL_BA + 256, DM, 64 * (r / 32), 32 * (r % 32), S_WB, scr, lane); return; } r -= I_BC;
    if (r < I_BCZ) { unsigned char* z = wl + WL_BA;
#pragma unroll
        for (int q = 0; q < 4; ++q) { const int idx = q * 64 + lane, row = r * 16 + (idx >> 4), ch = idx & 15; *(u32x4*)(z + (size_t)row * DM + (ch < 8 ? 384 : 896 - 128) + 16 * ch) = (u32x4){0u, 0u, 0u, 0u}; }
        return; } r -= I_BCZ;
    if (r < I_OUT) { transpose_item_fp8(args.wout + (size_t)l * DM * DM, DM, wl + WL_OUT, DM, 64 * (r / 32), 32 * (r % 32), S_WOUT, scr, lane); return; } r -= I_OUT;
    if (r < I_W1) { transpose_item<1, 0>(args.w1k + (size_t)l * 2048 * 128, 128, (bf16*)(wl + WL_W1K), 2048, 64 * (r / 4), 32 * (r % 4), scr, lane); return; } r -= I_W1;
    if (r < I_W1) { transpose_item<0, 0>(args.w1v + (size_t)l * 2048 * 128, 128, (bf16*)(wl + WL_W1V), 2048, 64 * (r / 4), 32 * (r % 4), scr, lane); return; } r -= I_W1;
    if (r < I_W2) { transpose_item<0, 1>(args.w2k + (size_t)l * 128 * 64, 64, (bf16*)(wl + WL_W2K), 128, 64 * (r / 2), 32 * (r % 2), scr, lane); return; } r -= I_W2;
    if (r < I_W2) { transpose_item<0, 0>(args.w2v + (size_t)l * 128 * 64, 64, (bf16*)(wl + WL_W2V), 128, 64 * (r / 2), 32 * (r % 2), scr, lane); return; } r -= I_W2;
    if (r < I_GU) { const int e = r / 1024, q = r % 1024; transpose_item_fp8(args.wgu + ((size_t)l * NEXP + e) * DM * 2048, 2048, wl + WL_GU + (size_t)e * 2048 * DM, DM, 64 * (q / 64), 32 * (q % 64), S_WGU, scr, lane); return; } r -= I_GU;
    { const int e = r / 512, q = r % 512; transpose_item_fp8(args.wdn + ((size_t)l * NEXP + e) * DM * DM, DM, wl + WL_DN + (size_t)e * DM * DM, DM, 64 * (q / 32), 32 * (q % 32), S_WDN, scr, lane); }
}

__global__ void __launch_bounds__(512, 2) fwd(Args args) {
    extern __shared__ __attribute__((aligned(16))) unsigned char lds_raw[];
    LAS unsigned char* lds = (LAS unsigned char*)lds_raw;
    volatile LAS unsigned* MISC = (volatile LAS unsigned*)(lds + MISC_OFF);
    LAS int* L_PSTART = (LAS int*)(lds + MISC_OFF + 256);
    LAS unsigned char* L_TEXP = lds + MISC_OFF + 512;
    LAS int* L_CNT = (LAS int*)(lds + MISC_OFF + 1280);
    LAS int* L_BASE = (LAS int*)(lds + MISC_OFF + 1408);
    LAS int* L_E = (LAS int*)(lds + MISC_OFF + 2048);
    LAS float* L_G = (LAS float*)(lds + MISC_OFF + 4096);
    const int G = gridDim.x, bx = blockIdx.x, NGW = G * 8;
    const int wave_s = __builtin_amdgcn_readfirstlane((int)threadIdx.x >> 6);
    { const int t0_ = threadIdx.x; for (int u = t0_; u < 64; u += 512) MISC[u] = 0u; }
    __syncthreads();
    XcdBarrier bar; bar.bar = (unsigned*)(args.ws + WS_CTL) + CW_BAR; bar.x = 0; bar.st = MISC + 8;
    if (args.use_bar) bar = xcd_barrier_post((unsigned*)(args.ws + WS_CTL) + CW_BAR, MISC + 8);
    const int lo = args.ph_lo, hi_ph = args.ph_hi;
#define IN(k) (lo <= (k) && (k) < hi_ph)
#define EN(j) ((PHMASK >> (j)) & 1)
#define SEAM(k) do { if (IN(k) && IN((k) + 1)) xcd_barrier(bar); } while (0)
#define PH_BEGIN \
    unsigned ones_ = ~0u; asm volatile("" : "+s"(ones_)); int tid = wave_s * 64 + (int)__builtin_amdgcn_mbcnt_hi(ones_, __builtin_amdgcn_mbcnt_lo(ones_, 0u)); asm volatile("" : "+v"(tid)); const int lane = tid & 63, wave = __builtin_amdgcn_readfirstlane(tid >> 6), gw = bx * 8 + wave; (void)gw; (void)lane; \
    unsigned long long wsi_ = (unsigned long long)args.ws; asm volatile("" : "+s"(wsi_)); unsigned char* ws = (unsigned char*)(GAS unsigned char*)wsi_;   unsigned* ctl = (unsigned*)(ws + WS_CTL); (void)ctl; \
    float* MOD = (float*)(ws + WS_MOD); float* WGc = (float*)(ws + WS_WG); float* B1P = (float*)(ws + WS_B1); float* WRT = (float*)(ws + WS_WRT); \
    float* COS = (float*)(ws + WS_CS); float* SIN = COS + (size_t)NT * 32; \
    bf16* KM = (bf16*)(ws + WS_KM); bf16* KC = (bf16*)(ws + WS_KC); bf16* VC = (bf16*)(ws + WS_VC); float* GL = (float*)(ws + WS_GL); \
    int* TOKE = (int*)(ws + WS_TOKE); float* TOKG = (float*)(ws + WS_TOKG); int* TOKO = (int*)(ws + WS_TOKO); float* ROWG = (float*)(ws + WS_ROWG); \
    bf16* Hb = (bf16*)(ws + WS_H); bf16* PROJ = (bf16*)(ws + WS_PROJ); bf16* XG = PROJ; bf16* YR = PROJ; \
    unsigned char* OA = ws + WS_OA; unsigned char* OB = OA + 512; unsigned char* OC = OA + 256;     \
    bf16* MERGED = (bf16*)(ws + WS_MERGED); float* X = (float*)(ws + WS_X); bf16* ACT = (bf16*)(ws + WS_ACT); \
    unsigned char* wl = ws + WS_WL + (size_t)l * WL_STRIDE; const float* modl = MOD + (size_t)l * 8 * 6 * DM; const float* xin = (l == 0) ? args.x : X; \
    (void)WGc; (void)B1P; (void)WRT; (void)SIN; (void)KM; (void)KC; (void)VC; (void)GL; (void)TOKE; (void)TOKG; (void)TOKO; (void)ROWG; (void)Hb; (void)XG; (void)YR; (void)OA; (void)OB; (void)OC; (void)MERGED; (void)ACT; (void)wl; (void)modl; (void)xin;

    if (EN(12) && IN(0)) {
        const int l = 0; PH_BEGIN
        {
            LAS float* cond = (LAS float*)lds;
            LAS float* part = (LAS float*)(lds + 32768);
            bool have = false;
            for (int it = bx; it < DEPTH * 96; it += G) {
                if (!have) { for (int i = tid; i < 8 * DM; i += 512) { const float v = args.c[i]; cond[i] = v * sigmoidf_(v); } __syncthreads(); have = true; }
                const int l = it / 96, n = (it % 96) * 64 + lane;
                const float* W = args.w_ada + (size_t)l * DM * 6 * DM + n;
                float acc[8];
#pragma unroll
                for (int b = 0; b < 8; ++b) acc[b] = 0.f;
#pragma unroll 8
                for (int k = wave * 128; k < wave * 128 + 128; ++k) { const float w = W[(size_t)k * 6 * DM];
#pragma unroll
                    for (int b = 0; b < 8; ++b) acc[b] += cond[b * DM + k] * w; }
#pragma unroll
                for (int b = 0; b < 8; ++b) part[(wave * 8 + b) * 64 + lane] = acc[b];
                __syncthreads();
                { const int b = tid >> 6; float s = 0.f;
#pragma unroll
                  for (int w = 0; w < 8; ++w) s += part[(w * 8 + b) * 64 + lane];
                  MOD[((size_t)l * 8 + b) * 6 * DM + n] = s + args.b_ada[(size_t)l * 6 * DM + n]; }
                __syncthreads();
            }
            __syncthreads();
        }
        {
            LAS float* part = (LAS float*)lds;
            for (int it = bx; it < DEPTH * 2 * 4; it += G) {
                const int l = it >> 3, kv = (it >> 2) & 1, kq = it & 3, j = tid & 127, sl = tid >> 7;
                const float* w1 = (kv ? args.w1v : args.w1k) + (size_t)l * 2048 * 128; const float* pe = (kv ? args.pev : args.pek) + (size_t)l * 2048;
                float s = 0.f;
#pragma unroll 8
                for (int k = kq * 512 + sl * 128; k < kq * 512 + sl * 128 + 128; ++k) s += pe[k] * w1[(size_t)k * 128 + j];
                part[sl * 128 + j] = s; __syncthreads();
                if (tid < 128) B1P[(size_t)((l * 2 + kv) * 4 + kq) * 128 + tid] = (part[tid] + part[128 + tid]) + (part[256 + tid] + part[384 + tid]);
                __syncthreads();
            }
        }
        for (size_t i = (size_t)bx * 512 + tid; i < (size_t)NT * 32; i += (size_t)G * 512) {
            const int tok = (int)(i >> 5), fi = (int)(i & 31);
            const float invf = __builtin_amdgcn_exp2f(-(float)fi * (13.287712379549449f / 32.0f));
            const double ang = (double)args.pos[tok] * (double)invf * 0.15915494309189535;
            const float fr = (float)(ang - floor(ang));
            COS[i] = __builtin_amdgcn_cosf(fr); SIN[i] = __builtin_amdgcn_sinf(fr);
        }
        for (int i = bx * 512 + tid; i < DEPTH * NGATE * DM; i += G * 512) { const int l = i / (NGATE * DM), o = (i / DM) % NGATE, k = i % DM; WGc[i] = args.w_in[((size_t)l * DM + k) * IN_W + O_BG + o]; }
        for (int i = bx * 512 + tid; i < DEPTH * NEXP * DM; i += G * 512) { const int l = i / (NEXP * DM), e = (i / DM) % NEXP, k = i % DM; WRT[i] = args.rw[((size_t)l * DM + k) * NEXP + e]; }
        {
            LAS float* scr = (LAS float*)(lds + wave * 16384);
            for (int it = gw; it < I_SM; it += NGW) cv_item(args, ws, 0, it, scr, lane);
        }
    }
    SEAM(0);

#pragma nounroll
    for (int l = 0; l < DEPTH; ++l) {
        const int P = 1 + 12 * l;

        if (EN(0) && IN(P + 0) && l == 0) {
            PH_BEGIN
            LAS float* wg = (LAS float*)lds; lds_fill(wg, WGc + (size_t)l * NGATE * DM, NGATE * DM, tid); __syncthreads();
            const int rpw = NT / NGW;
#pragma nounroll
            for (int i = 0; i < rpw; i += 2) { const int row = gw * rpw + i;
                Row r0, r1; row_load(r0, xin + (size_t)row * DM, lane); row_load(r1, xin + (size_t)(row + 1) * DM, lane);
                ln1_row(r0, modl + (size_t)(row / SEQ) * 6 * DM, wg, Hb + (size_t)row * DM, ws + WS_H8 + (size_t)row * DM, GL + (size_t)row * NGATE, lane);
                ln1_row(r1, modl + (size_t)((row + 1) / SEQ) * 6 * DM, wg, Hb + (size_t)(row + 1) * DM, ws + WS_H8 + (size_t)(row + 1) * DM, GL + (size_t)(row + 1) * NGATE, lane); }
            __syncthreads();
        }
        SEAM(P + 0);

        if (EN(1) && IN(P + 1)) {
            PH_BEGIN
            pg8::TileOrder S; S.init(ws + WS_H8, wl + WL_IN, NT / 256, 24, DM / 2, G, bx);
            S.noepi = args.qsel == 2;
            EpiProj E{PROJ, COS, SIN, (bf16*)(ws + WS_KF), 0, 1.0f / (S_H * S_WIN), ws + WS_G8};
            pg8::gemm_phase<EpiProj, true, false, true>(lds, DM / 2, S, E, tid);
        }
        SEAM(P + 1);

        if (EN(2) && IN(P + 2)) {
            PH_BEGIN
            for (int it = bx; it < 256; it += G) { const int b = it >> 5, g = (it >> 4) & 1, kv = (it >> 3) & 1, nt = it & 7;
                if (kv == 0) cmp_unit_wg(PROJ, (const bf16*)(wl + WL_W1K), (const bf16*)(wl + WL_W2K), B1P + (size_t)(l * 2 + 0) * 512, KC, b, g, C_BKC + g * 64, nt, (LAS float*)lds, wave, lane);
                else         cmp_unit_wg(PROJ, (const bf16*)(wl + WL_W1V), (const bf16*)(wl + WL_W2V), B1P + (size_t)(l * 2 + 1) * 512, VC, b, g, C_BVC + g * 64, nt, (LAS float*)lds, wave, lane); }
            for (int it = gw; it < 512; it += NGW) prep_km((const bf16*)(ws + WS_KF), KM, it, lane);
        }
        SEAM(P + 2);

        if (EN(3) && IN(P + 3)) {
            PH_BEGIN
            const AttnCtx C{PROJ, (const bf16*)(ws + WS_KF), KM, KC, VC, GL, OA, OB, OC, (unsigned*)(ws + WS_SELM)};
            LAS unsigned char* vimg = lds + wave * 16384;
            unsigned* qb = ctl + CW_Q + (((args.qsel != 0) * 2 + l) * 4) * 8 * 64;
            for (int xo = 0; xo < 8; ++xo) { const int x = (bx + xo) & 7; unsigned* q = qb + (0 * 8 + x) * 64;
                for (;;) { const unsigned u = wave_pop(q, lane); if (u >= 256u) break;
                    const int ci = u & 7, bg = 2 * x + ((u >> 3) & 1), cg = u >> 4; nsa_cmp(C, bg >> 1, bg & 1, (127 - (cg * 8 + ci)) * 32, vimg, lane); } }
        }
        SEAM(P + 3);

        if (EN(4) && IN(P + 4)) {
            PH_BEGIN
            const AttnCtx C{PROJ, (const bf16*)(ws + WS_KF), KM, KC, VC, GL, OA, OB, OC, (unsigned*)(ws + WS_SELM)};
            LAS unsigned char* vimg = lds + wave * 16384;
            unsigned* qb = ctl + CW_Q + (((args.qsel != 0) * 2 + l) * 4) * 8 * 64;
            {
                MISC[32 + wave] = (unsigned)__builtin_amdgcn_s_getreg((1 << 11) | (4 << 6) | 4) & 3u;
                __syncthreads();
                const unsigned my_simd = MISC[32 + wave]; int rank = 0;
                for (int w = 0; w < wave; ++w) rank += (MISC[32 + w] == my_simd) ? 1 : 0;
                if (__builtin_amdgcn_readfirstlane(rank) == 0 && __builtin_amdgcn_readfirstlane((int)my_simd) < CV_WAVES) {
                    unsigned* cq = ctl + CW_CV + l * 64;
                    for (;;) { const int base = CV_POP * (int)wave_pop(cq, lane); if (base >= I_GU + I_DN) break;
#pragma nounroll
                        for (int g = 0; g < CV_POP; g += CV_DEPTH) {
                            float stg[CV_DEPTH][32]; CvDesc d[CV_DEPTH];
#pragma unroll
                            for (int t = 0; t < CV_DEPTH; ++t) { d[t] = cv_desc(args, ws, l, base + g + t); cv_ld(stg[t], d[t], lane); }
                            asm volatile("" ::: "memory");
#pragma unroll
                            for (int t = 0; t < CV_DEPTH; ++t) cv_st(stg[t], d[t], lane);
                        } }
                    if (l + 1 < DEPTH) { LAS float* scr = (LAS float*)(lds + wave * 16384);
                        for (;;) { const int base = 8 * (int)wave_pop(cq + 32, lane); if (base >= I_SM) break;
#pragma nounroll
                            for (int t = 0; t < 8; ++t) cv_item(args, ws, l + 1, base + t, scr, lane); } }
                }
            }
            if (args.amask & 1) for (int xo = 0; xo < 8; ++xo) { const int x = (bx + xo) & 7; unsigned* q = qb + (1 * 8 + x) * 64;
                for (;;) { const unsigned u = wave_pop(q, lane); if (u >= 512u) break;
                    const int ci = u & 7, part = (u >> 3) & 1, bg = 2 * x + ((u >> 4) & 1), cg = u >> 5; nsa_rest(C, bg >> 1, bg & 1, (127 - (cg * 8 + ci)) * 32, part, vimg, lane); } }
            if (args.amask & 2) for (int xo = 0; xo < 8; ++xo) { const int x = (bx + xo) & 7; unsigned* q = qb + (2 * 8 + x) * 64;
                for (;;) { const unsigned u = wave_pop(q, lane); if (u >= 256u) break;
                    const int ci = u & 7, bh = 4 * x + ((u >> 3) & 3), cg = u >> 5; moba_unit(C, bh >> 2, bh & 3, (63 - (cg * 8 + ci)) * 64, vimg, lane); } }
            if (args.amask & 4) for (int xo = 0; xo < 8; ++xo) { const int x = (bx + xo) & 7; unsigned* q = qb + (3 * 8 + x) * 64;
                for (;;) { const unsigned u = wave_pop(q, lane); if (u >= 256u) break;
                    const int ci = u & 7, bh = 2 * x + ((u >> 3) & 1), r2 = (u >> 4) & 1, lt = 7 - (int)(u >> 5); dil_unit(C, bh >> 1, bh & 1, r2 * 8 + ci, lt, vimg, lane); } }
        }
        SEAM(P + 4);

        if (EN(5) && IN(P + 5)) {
            PH_BEGIN
            pg8::TileOrder S; S.init(OA, wl + WL_BA, NT / 256, 4, DM / 2, G, bx); EpiBranchF E{MERGED, ws + WS_G8};
            pg8::gemm_phase<EpiBranchF, true, false, true>(lds, DM / 2, S, E, tid);
        }
        SEAM(P + 5);

        if (EN(6) && IN(P + 6)) {
            PH_BEGIN
            pg8::TileOrder S; S.init(MERGED, wl + WL_OUT, NT / 256, 4, DM / 2, G, bx);
            EpiOut E{PROJ};
            pg8::gemm_phase<EpiOut, true, false, true>(lds, DM / 2, S, E, tid);
        }
        SEAM(P + 6);

        if (EN(7) && IN(P + 7)) {
            PH_BEGIN
            LAS float* wr = (LAS float*)lds; lds_fill(wr, WRT + (size_t)l * NEXP * DM, NEXP * DM, tid);
            if (tid < 32) L_CNT[tid] = 0;
            LAS float* plg = (LAS float*)(lds + MISC_OFF + 6144); LAS float* plb = plg + DM; LAS float* prb = plb + DM;
            if (tid < NEXP) prb[tid] = args.rb[(size_t)l * NEXP + tid];
            for (int i = tid * 4; i < 2 * DM; i += 512 * 4) *(LAS f32x4*)(plg + i) = *(const f32x4*)(i < DM ? args.ln1g + (size_t)l * DM + i : args.ln1b + (size_t)l * DM + (i - DM));
            __syncthreads();
            const int RPW = NT / G, RPV = RPW / 8;
            const bool dry = args.qsel != 0;
            bf16* Xo = dry ? (bf16*)ACT : (bf16*)X; unsigned char* Ho = dry ? ((unsigned char*)ACT + 136 * MiB) : (ws + WS_H8);
            struct PR { u32x4 x0[4], x1[4]; u32x2 y0[4], y1[4]; };
            const bf16* Yb = PROJ;
            struct PP { Vec g1, sc, sh; };
            auto pp_load = [&](PP& p, int i) { const int row0 = bx * RPW + wave * RPV + i; const float* modb = modl + (size_t)(row0 / SEQ) * 6 * DM;
                vec_load(p.g1, modb + 2 * DM, lane); vec_load(p.sc, modb + 4 * DM, lane); vec_load(p.sh, modb + 3 * DM, lane); };
            auto pair_body = [&](PR& f, const PP& pp, int i) {
                const int lr0 = wave * RPV + i, row0 = bx * RPW + lr0;
                Row r0, r1;
#pragma unroll
                for (int j = 0; j < 4; ++j) { const u32x4 a = f.x0[j], b = f.x1[j];
                    if (l == 0) { r0.v[j] = (f32x4){__uint_as_float(a.x), __uint_as_float(a.y), __uint_as_float(a.z), __uint_as_float(a.w)}; r1.v[j] = (f32x4){__uint_as_float(b.x), __uint_as_float(b.y), __uint_as_float(b.z), __uint_as_float(b.w)}; }
                    else { r0.v[j] = (f32x4){bf_lo(a.x), bf_hi(a.x), bf_lo(a.y), bf_hi(a.y)}; r1.v[j] = (f32x4){bf_lo(b.x), bf_hi(b.x), bf_lo(b.y), bf_hi(b.y)}; } }
#pragma unroll
                for (int j = 0; j < 4; ++j) { const f32x4 g1v = pp.g1.v[j]; const u32x2 ya = f.y0[j], yb = f.y1[j];
                    r0.v[j] = r0.v[j] * ALPHA + g1v * (f32x4){bf_lo(ya.x), bf_hi(ya.x), bf_lo(ya.y), bf_hi(ya.y)}; r1.v[j] = r1.v[j] * ALPHA + g1v * (f32x4){bf_lo(yb.x), bf_hi(yb.x), bf_lo(yb.y), bf_hi(yb.y)}; }
                row_ln(r0); row_affine_l(r0, plg, plb, 0.0f, lane); row_store_bf16(r0, Xo + (size_t)row0 * DM, lane);
                row_ln(r1); row_affine_l(r1, plg, plb, 0.0f, lane); row_store_bf16(r1, Xo + (size_t)(row0 + 1) * DM, lane);
                row_ln(r0); row_affine_r(r0, pp.sc, pp.sh, 1.0f); row_store_fp8(r0, Ho + (size_t)row0 * DM, S_H, lane);
                row_ln(r1); row_affine_r(r1, pp.sc, pp.sh, 1.0f); row_store_fp8(r1, Ho + (size_t)(row0 + 1) * DM, S_H, lane);
                const int sub = (lane >> 1) & 7;
                float lg[2][4];
#pragma unroll
                for (int cch = 0; cch < 4; ++cch) { lg[0][cch] = 0.f; lg[1][cch] = 0.f; }
#pragma nounroll
                for (int cch = 0; cch < 4; ++cch) {
                    float a0[8], a1[8];
                    const LAS float* wp = wr + (cch * 8) * DM + 4 * lane;
                    f32x4 wa[4], wb[4]; wvec_lds(wa, wp);
#pragma unroll
                    for (int e8 = 0; e8 < 8; e8 += 2) {
                        wvec_lds(wb, wp + (e8 + 1) * DM); asm volatile("" ::: "memory"); WVEC_TOUCH(wa);
                        a0[e8] = row_dot(r0, wa); a1[e8] = row_dot(r1, wa);
                        if (e8 + 2 < 8) wvec_lds(wa, wp + (e8 + 2) * DM);
                        asm volatile("" ::: "memory"); WVEC_TOUCH(wb);
                        a0[e8 + 1] = row_dot(r0, wb); a1[e8 + 1] = row_dot(r1, wb); }
                    const float rbv = prb[cch * 8 + sub];
                    const float v0 = reduce_scatter8(a0, lane) + rbv, v1 = reduce_scatter8(a1, lane) + rbv;
#pragma unroll
                    for (int q = 0; q < 4; ++q) { lg[0][q] = (q == cch) ? v0 : lg[0][q]; lg[1][q] = (q == cch) ? v1 : lg[1][q]; }
                }
#pragma unroll
                for (int rr = 0; rr < 2; ++rr) {
                    float tv[4]; int te[4]; unsigned kk[4];
#pragma unroll
                    for (int cch = 0; cch < 4; ++cch) { const unsigned u = __float_as_uint(lg[rr][cch]); const unsigned o = (u & 0x80000000u) ? ~u : (u | 0x80000000u); kk[cch] = (o & ~31u) | (unsigned)(31 - (cch * 8 + sub)); }
#pragma unroll
                    for (int k = 0; k < 4; ++k) {
                        unsigned bk = max(max(kk[0], kk[1]), max(kk[2], kk[3]));
                        bk = max(bk, (unsigned)dpp_i<0x4E>((int)bk)); bk = max(bk, (unsigned)dpp_i<0x141>((int)bk)); bk = max(bk, (unsigned)dpp_i<0x140>((int)bk));
                        te[k] = 31 - (int)(bk & 31u); { const unsigned o = bk & ~31u; tv[k] = __uint_as_float((o & 0x80000000u) ? (o & 0x7fffffffu) : ~o); }
#pragma unroll
                        for (int cch = 0; cch < 4; ++cch) kk[cch] = (kk[cch] == bk) ? 0u : kk[cch];
                    }
                    const float e1 = fast_exp(tv[1] - tv[0]), e2 = fast_exp(tv[2] - tv[0]), e3 = fast_exp(tv[3] - tv[0]); const float inv = 1.0f / (1.0f + e1 + e2 + e3);
                    if (lane < 4) { const float gk = (lane == 0 ? 1.0f : (lane == 1 ? e1 : (lane == 2 ? e2 : e3))) * inv; const int ek = lane == 0 ? te[0] : (lane == 1 ? te[1] : (lane == 2 ? te[2] : te[3]));
                        L_E[(lr0 + rr) * 4 + lane] = ek; L_G[(lr0 + rr) * 4 + lane] = gk; }
                }
            };
            auto pr_load = [&](PR& f, int i) { const int row0 = bx * RPW + wave * RPV + i;
                if (l == 0) {
#pragma unroll
                    for (int j = 0; j < 4; ++j) { f.x0[j] = *(const u32x4*)(args.x + (size_t)row0 * DM + 256 * j + 4 * lane); f.x1[j] = *(const u32x4*)(args.x + (size_t)(row0 + 1) * DM + 256 * j + 4 * lane); }
                } else {
#pragma unroll
                    for (int j = 0; j < 4; ++j) { const u32x2 a = *(const u32x2*)((const bf16*)X + (size_t)row0 * DM + 256 * j + 4 * lane), b = *(const u32x2*)((const bf16*)X + (size_t)(row0 + 1) * DM + 256 * j + 4 * lane);
                        f.x0[j] = (u32x4){a.x, a.y, 0u, 0u}; f.x1[j] = (u32x4){b.x, b.y, 0u, 0u}; }
                }
#pragma unroll
                for (int j = 0; j < 4; ++j) { f.y0[j] = *(const u32x2*)(Yb + (size_t)row0 * DM + 256 * j + 4 * lane); f.y1[j] = *(const u32x2*)(Yb + (size_t)(row0 + 1) * DM + 256 * j + 4 * lane); } };
            auto pr_touch = [&](PR& f) { asm volatile("" :: "v"(f.x0[0]), "v"(f.x0[1]), "v"(f.x0[2]), "v"(f.x0[3]), "v"(f.x1[0]), "v"(f.x1[1]), "v"(f.x1[2]), "v"(f.x1[3]));
                asm volatile("" :: "v"(f.y0[0]), "v"(f.y0[1]), "v"(f.y0[2]), "v"(f.y0[3]), "v"(f.y1[0]), "v"(f.y1[1]), "v"(f.y1[2]), "v"(f.y1[3])); };
            PR A, B; PP pp; pr_load(A, 0);
#pragma nounroll
            for (int i = 0; i < RPV; i += 4) {
                pp_load(pp, i); asm volatile("" ::: "memory"); pr_touch(A); pr_load(B, i + 2); asm volatile("" ::: "memory"); pair_body(A, pp, i);
                pp_load(pp, i + 2); asm volatile("" ::: "memory"); pr_touch(B); pr_load(A, i + 4 < RPV ? i + 4 : RPV - 2); asm volatile("" ::: "memory"); pair_body(B, pp, i + 2);
            }
            pr_touch(A);
            __syncthreads();
            int my_e = 0, my_rank = 0;
            if (tid < RPW * 4) { my_e = L_E[tid]; my_rank = __hip_atomic_fetch_add(&L_CNT[my_e], 1, __ATOMIC_RELAXED, __HIP_MEMORY_SCOPE_WORKGROUP); }
            __syncthreads();
            if (tid < 32 && !dry) L_BASE[tid] = (int)__hip_atomic_fetch_add(ctl + CW_CUR + (l * 32 + tid) * 64, (unsigned)L_CNT[tid], __ATOMIC_RELAXED, __HIP_MEMORY_SCOPE_AGENT);
            __syncthreads();
            if (tid < RPW * 4 && !dry) { const int gi = bx * RPW * 4 + tid; const int slot = L_BASE[my_e] + my_rank; TOKE[gi] = my_e; TOKO[gi] = slot;
                ((int*)(ws + WS_RT))[(size_t)my_e * 32768 + slot] = gi >> 2; ((float*)(ws + WS_RT + 4 * MiB))[(size_t)my_e * 32768 + slot] = L_G[tid]; }
            __syncthreads();
        }
        SEAM(P + 7);

        if ((EN(8) || EN(9) || EN(10)) && (IN(P + 8) || IN(P + 9) || IN(P + 10))) {
            PH_BEGIN
            if (tid < 32) {
                const int cnt = (int)__hip_atomic_load(ctl + CW_CUR + (l * 32 + tid) * 64, RLX_AGENT); const int nt_ = (cnt + 255) >> 8;
                int incl = nt_;
#pragma unroll
                for (int o = 1; o < 32; o <<= 1) { const int t = __shfl_up(incl, o); if (tid >= o) incl += t; }
                const int first = incl - nt_;
                L_PSTART[tid] = first << 8; L_CNT[tid] = cnt;
#pragma nounroll
                for (int t = 0; t < nt_; ++t) L_TEXP[first + t] = (unsigned char)tid;
                if (tid == 31) MISC[16] = (unsigned)incl;
            }
            __syncthreads();
        }
        const int ntiles = (int)MISC[16];
        if (EN(9) && IN(P + 9)) {
            PH_BEGIN
            pg8::TileOrder S; S.init(ws + WS_H8, wl + WL_GU, ntiles, 8, DM / 2, G, bx, (size_t)2048 * DM, L_TEXP, L_PSTART, L_CNT, (const int*)(ws + WS_RT), true);
            EpiGU E{(unsigned char*)ACT, args.bgu + (size_t)l * NEXP * 2048}; S.noepi = args.qsel == 2;
            pg8::gemm_phase<EpiGU, true, true, true>(lds, DM / 2, S, E, tid);
        }
        SEAM(P + 9);
        if (EN(10) && IN(P + 10)) {
            PH_BEGIN
            pg8::TileOrder S; S.init(ACT, wl + WL_DN, ntiles, 4, DM / 2, G, bx, (size_t)DM * DM, L_TEXP, L_PSTART, L_CNT);
            EpiDN E{YR, args.bdn + (size_t)l * NEXP * DM, (const float*)(ws + WS_RT + 4 * MiB)};
            pg8::gemm_phase<EpiDN, true, false, true>(lds, DM / 2, S, E, tid);
        }
        SEAM(P + 10);

        if (EN(11) && IN(P + 11)) {
            PH_BEGIN
            if (tid < 32) { const int cnt = (int)__hip_atomic_load(ctl + CW_CUR + (l * 32 + tid) * 64, RLX_AGENT); const int nt_ = (cnt + 255) >> 8; int incl = nt_;
#pragma unroll
                for (int o = 1; o < 32; o <<= 1) { const int t = __shfl_up(incl, o); if (tid >= o) incl += t; }
                L_PSTART[tid] = (incl - nt_) << 8; }
            const bool more = (l + 1 < DEPTH);
            LAS float* wg = (LAS float*)lds; if (more) lds_fill(wg, WGc + (size_t)(l + 1) * NGATE * DM, NGATE * DM, tid);
            LAS float* pv = (LAS float*)(lds + 81920);
            { const int bq = (bx * (NT / G)) / SEQ; const float* modb = modl + (size_t)bq * 6 * DM; const float* mn = MOD + (size_t)(l + 1) * 8 * 6 * DM + (size_t)bq * 6 * DM;
              for (int i = tid * 4; i < (more ? 5 : 3) * DM; i += 512 * 4) { const int wv = i / DM, k = i % DM;
                  const float* src = wv == 0 ? modb + 5 * DM : (wv == 1 ? args.ln2g + (size_t)l * DM : (wv == 2 ? args.ln2b + (size_t)l * DM : (wv == 3 ? mn + DM : mn)));
                  *(LAS f32x4*)(pv + i) = *(const f32x4*)(src + k); } }
            __syncthreads();
            const bool dry = args.qsel != 0;
            float* dstf = dry ? (float*)ACT : args.out; bf16* dstb = dry ? (bf16*)ACT : (bf16*)X; bf16* Ho = dry ? (bf16*)((unsigned char*)ACT + 136 * MiB) : Hb; float* GLo = dry ? (float*)((unsigned char*)ACT + 208 * MiB) : GL; unsigned char* H8o = dry ? ((unsigned char*)ACT + 216 * MiB) : (ws + WS_H8);
            const int rpw = NT / NGW;
            int dest_l = 0; if (lane < rpw * 4) { const int gi = gw * rpw * 4 + lane; dest_l = L_PSTART[TOKE[gi]] + TOKO[gi]; }
            struct PF { u32x2 x[4]; unsigned y[4][4]; };
            auto pf_load = [&](PF& f, int i) { const int row = gw * rpw + i;
#pragma unroll
                for (int j = 0; j < 4; ++j) f.x[j] = *(const u32x2*)((const bf16*)X + (size_t)row * DM + 256 * j + 4 * lane);
#pragma unroll
                for (int k = 0; k < 4; ++k) { const unsigned char* yp = (const unsigned char*)YR + (size_t)__builtin_amdgcn_readlane(dest_l, 4 * i + k) * DM;
#pragma unroll
                    for (int j = 0; j < 4; ++j) f.y[k][j] = *(const unsigned*)(yp + 256 * j + 4 * lane); } };
            auto pf_touch = [&](PF& f) {
                asm volatile("" :: "v"(f.x[0]), "v"(f.x[1]), "v"(f.x[2]), "v"(f.x[3]));
#pragma unroll
                for (int k = 0; k < 4; ++k) asm volatile("" :: "v"(f.y[k][0]), "v"(f.y[k][1]), "v"(f.y[k][2]), "v"(f.y[k][3])); };
            auto pf_row = [&](PF& f, int i) {
                const int row = gw * rpw + i;
                Row r, y;
#pragma unroll
                for (int j = 0; j < 4; ++j) r.v[j] = (f32x4){bf_lo(f.x[j].x), bf_hi(f.x[j].x), bf_lo(f.x[j].y), bf_hi(f.x[j].y)};
#pragma unroll
                for (int j = 0; j < 4; ++j) y.v[j] = (f32x4){0.f, 0.f, 0.f, 0.f};
#pragma unroll
                for (int k = 0; k < 4; ++k)
#pragma unroll
                    for (int j = 0; j < 4; ++j) { const int w = (int)f.y[k][j]; y.v[j] += (f32x4){__builtin_amdgcn_cvt_f32_fp8(w, 0), __builtin_amdgcn_cvt_f32_fp8(w, 1), __builtin_amdgcn_cvt_f32_fp8(w, 2), __builtin_amdgcn_cvt_f32_fp8(w, 3)}; }
#pragma unroll
                for (int j = 0; j < 4; ++j) { const f32x4 ga = *(const LAS f32x4*)(pv + 256 * j + 4 * lane) * (1.0f / S_Y); r.v[j] = r.v[j] * ALPHA + ga * y.v[j]; }
                row_ln(r); row_affine_l(r, pv + DM, pv + 2 * DM, 0.0f, lane); if (more) row_store_bf16(r, dstb + (size_t)row * DM, lane); else row_store(r, dstf + (size_t)row * DM, lane);
                if (more) { row_ln(r); row_affine_l(r, pv + 3 * DM, pv + 4 * DM, 1.0f, lane); ln1_tail(r, wg, Ho + (size_t)row * DM, H8o + (size_t)row * DM, GLo + (size_t)row * NGATE, lane); } };
            PF A, B; pf_load(A, 0);
#pragma nounroll
            for (int i = 0; i < rpw; i += 2) {
                pf_touch(A); pf_load(B, i + 1); pf_row(A, i);
                pf_touch(B); pf_load(A, i + 2 < rpw ? i + 2 : rpw - 1); pf_row(B, i + 1);
            }
            pf_touch(A);
            __syncthreads();
        }
        SEAM(P + 11);
    }
#undef IN
#undef SEAM
#undef PH_BEGIN
}

extern "C" void kernel_launch(void* const* d_in, const int* in_sizes, int n_in, void* d_out, int out_size, void* d_ws, size_t ws_size, hipStream_t stream) {
    static int grid = 0;
    if (grid == 0) {
        if (n_in != 26 || in_sizes[0] != NT * DM || out_size != NT * DM || ws_size < WS_END) { fprintf(stderr, "kernel_launch: unexpected shapes (n_in %d, in0 %d, out %d, ws %zu)\n", n_in, n_in > 0 ? in_sizes[0] : -1, out_size, ws_size); grid = -1; return; }
        int dev = 0, cus = 0, per_cu = 0;
        if (hipGetDevice(&dev) != hipSuccess || hipDeviceGetAttribute(&cus, hipDeviceAttributeMultiprocessorCount, dev) != hipSuccess) { grid = -1; return; }
        if (hipFuncSetAttribute((const void*)fwd, hipFuncAttributeMaxDynamicSharedMemorySize, LDS_BYTES) != hipSuccess) { fprintf(stderr, "kernel_launch: hipFuncSetAttribute failed\n"); grid = -1; return; }
        if (hipOccupancyMaxActiveBlocksPerMultiprocessor(&per_cu, (const void*)fwd, 512, LDS_BYTES) != hipSuccess || per_cu < 1) fprintf(stderr, "kernel_launch: occupancy query reports %d\n", per_cu);
        (void)hipGetLastError();
        if (cus < 256) { fprintf(stderr, "kernel_launch: %d CUs < 256: the persistent grid of 256 workgroups would not be resident\n", cus); grid = -1; return; }
        grid = 256;
    }
    if (grid < 0) return;
    if (hipMemsetAsync((char*)d_ws + WS_CTL, 0, CTL_BYTES, stream) != hipSuccess) return;
    Args a; memset(&a, 0, sizeof(a));
    a.x = (const float*)d_in[0]; a.c = (const float*)d_in[1]; a.pos = (const int*)d_in[2]; a.w_ada = (const float*)d_in[3]; a.b_ada = (const float*)d_in[4]; a.w_in = (const float*)d_in[5];
    a.w1k = (const float*)d_in[6]; a.w2k = (const float*)d_in[7]; a.pek = (const float*)d_in[8]; a.w1v = (const float*)d_in[9]; a.w2v = (const float*)d_in[10]; a.pev = (const float*)d_in[11];
    a.wba = (const float*)d_in[12]; a.wbb = (const float*)d_in[13]; a.wbc = (const float*)d_in[14]; a.wout = (const float*)d_in[15]; a.ln1g = (const float*)d_in[16]; a.ln1b = (const float*)d_in[17];
    a.rw = (const float*)d_in[18]; a.rb = (const float*)d_in[19]; a.wgu = (const float*)d_in[20]; a.bgu = (const float*)d_in[21]; a.wdn = (const float*)d_in[22]; a.bdn = (const float*)d_in[23];
    a.ln2g = (const float*)d_in[24]; a.ln2b = (const float*)d_in[25];
    a.out = (float*)d_out; a.ws = (unsigned char*)d_ws;
#if MK_ONE_LAUNCH
    a.ph_lo = 0; a.ph_hi = NPH; a.use_bar = 1; a.amask = 7;
    hipLaunchKernelGGL(fwd, dim3(grid), dim3(512), LDS_BYTES, stream, a);
#else
    a.use_bar = 0; a.amask = 7;
    for (int ph = 0; ph < NPH; ++ph) { a.ph_lo = ph; a.ph_hi = ph + 1; a.qsel = 0; hipLaunchKernelGGL(fwd, dim3(grid), dim3(512), LDS_BYTES, stream, a);
#if defined(PROBE_REP_A)
        if (ph == PROBE_REP_A) { a.qsel = PROBE_QSEL; a.amask = PROBE_AMASK; hipLaunchKernelGGL(fwd, dim3(grid), dim3(512), LDS_BYTES, stream, a); a.amask = 7; }
#endif
#if defined(PROBE_REP_B)
        if (ph == PROBE_REP_B) { a.qsel = 1; hipLaunchKernelGGL(fwd, dim3(grid), dim3(512), LDS_BYTES, stream, a); }
#endif
    }
#endif
    const hipError_t le = hipPeekAtLastError();
    if (le != hipSuccess) fprintf(stderr, "kernel_launch: launch failed: %s\n", hipGetErrorName(le));
}
```

```cpp
#include <hip/hip_runtime.h>
#include <cstdio>
#include <cstdint>
#include <cmath>
#include <cstring>

#define LAS __attribute__((address_space(3)))
#define GAS __attribute__((address_space(1)))
typedef unsigned short bf16;
typedef short bf16x8 __attribute__((ext_vector_type(8)));
typedef short s16x4 __attribute__((ext_vector_type(4)));
typedef float f32x2 __attribute__((ext_vector_type(2)));
typedef float f32x4 __attribute__((ext_vector_type(4)));
typedef float f32x16 __attribute__((ext_vector_type(16)));
typedef unsigned u32x2 __attribute__((ext_vector_type(2)));
typedef unsigned u32x4 __attribute__((ext_vector_type(4)));
typedef __bf16 bf16x2_t __attribute__((ext_vector_type(2)));
typedef int v4i32 __attribute__((ext_vector_type(4)));
typedef int v8i32 __attribute__((ext_vector_type(8)));
typedef GAS unsigned gu32;
#define DI __device__ __forceinline__
#define RLX_AGENT __ATOMIC_RELAXED, __HIP_MEMORY_SCOPE_AGENT

#ifndef PROBE_QSEL
#define PROBE_QSEL 1
#endif
#ifndef PROBE_AMASK
#define PROBE_AMASK 7
#endif
#ifndef ATT_MASK
#define ATT_MASK 7
#endif
#ifndef PHMASK
#define PHMASK 0xFFFF
#endif
#ifndef MK_ONE_LAUNCH
#define MK_ONE_LAUNCH 1
#endif

constexpr int BATCH = 8, SEQ = 4096, DM = 1024, NT = BATCH * SEQ, DEPTH = 2, HD = 64;
constexpr int PP = 6144;
constexpr int C_AQ = 0, C_AK = 256, C_BQ = 512, C_BKC = 896, C_BKS = 1024, C_BKW = 1152, C_CQ = 1280, C_CK = 1664;
constexpr int C_AV = 2048, C_BVC = 2304, C_BVS = 2432, C_BVW = 2560, C_CV = 2688, C_MG = 3072;
constexpr int O_AQ = 0, O_AK = 256, O_AV = 512, O_BQ = 768, O_BKC = 1152, O_BVC = 1280, O_BKS = 1408, O_BVS = 1536, O_BKW = 1664, O_BVW = 1792, O_BG = 1920,
              O_CQ = 1938, O_CK = 2322, O_CV = 2706, O_MG = 3090, IN_W = 6162;
constexpr unsigned QHEADS = 0x03F03F0Fu;
constexpr int NEXP = 32, TOPK = 4, MAXROWS = NT * TOPK + NEXP * 256, MAXTILES = MAXROWS / 256;
constexpr float LN_EPS = 1e-5f, ALPHA = 1.4142135623730951f  ;
constexpr float C2 = 0.125f * 1.4426950408889634f;
constexpr int NGATE = 18;

constexpr size_t MiB = 1u << 20;
constexpr size_t WS_CTL = 0, CTL_BYTES = 192 * 1024;
constexpr size_t WS_MOD = 2 * MiB;
constexpr size_t WS_WG = 3 * MiB;
constexpr size_t WS_B1 = WS_WG + 256 * 1024;
constexpr size_t WS_WRT = WS_B1 + 64 * 1024;
constexpr size_t WS_CS = 4 * MiB;
constexpr size_t WS_KM = 12 * MiB;
constexpr size_t WS_KC = WS_KM + 256 * 1024;
constexpr size_t WS_VC = WS_KC + 512 * 1024;
constexpr size_t WS_GL = 14 * MiB;
constexpr size_t WS_SELM = WS_GL + 2304 * 1024;
constexpr size_t WS_TOKE = 17 * MiB, WS_TOKG = WS_TOKE + 512 * 1024, WS_TOKO = WS_TOKG + 512 * 1024, WS_ROWG = WS_TOKO + 512 * 1024;
constexpr size_t WS_WL = 20 * MiB, WL_STRIDE = 210 * MiB;
constexpr size_t WL_IN = 0, WL_BA = 12 * MiB, WL_BB = WL_BA + 512 * 1024, WL_BC = WL_BB + 768 * 1024, WL_OUT = 14 * MiB, WL_W1K = 16 * MiB, WL_W1V = WL_W1K + 512 * 1024,
                 WL_W2K = 17 * MiB, WL_W2V = WL_W2K + 64 * 1024, WL_GU = 18 * MiB, WL_DN = 146 * MiB;
constexpr size_t WS_H = 440 * MiB;
constexpr size_t WS_PROJ = 504 * MiB;
constexpr size_t WS_OA = 888 * MiB, WS_OB = 904 * MiB, WS_OC = 928 * MiB;
constexpr size_t WS_MERGED = 944 * MiB;
constexpr size_t WS_X = 1008 * MiB;
constexpr size_t WS_ACT = 1136 * MiB;
constexpr size_t WS_KF = 1408 * MiB;
constexpr size_t WS_RT = 1466 * MiB;
constexpr size_t WS_H8 = 1476 * MiB;
constexpr size_t WS_G8 = 1508 * MiB;
constexpr size_t WS_END = 1604 * MiB;
constexpr int CW_BAR = 4096, CW_Q = 8192, CW_CUR = 32768;
constexpr int RING_BYTES = 131072, MISC_OFF = RING_BYTES, LDS_BYTES = 147456;

DI unsigned cvt_pk(float lo, float hi) { f32x2 v = {lo, hi}; bf16x2_t b = __builtin_convertvector(v, bf16x2_t); return __builtin_bit_cast(unsigned, b); }
DI unsigned cvt_fp8x4(float a, float b, float c, float d) {
    a = fminf(fmaxf(a, -448.f), 448.f); b = fminf(fmaxf(b, -448.f), 448.f); c = fminf(fmaxf(c, -448.f), 448.f); d = fminf(fmaxf(d, -448.f), 448.f);
    int w = __builtin_amdgcn_cvt_pk_fp8_f32(a, b, 0, false); w = __builtin_amdgcn_cvt_pk_fp8_f32(c, d, w, true); return (unsigned)w; }
DI float bf_lo(unsigned w) { return __uint_as_float(w << 16); }
DI float bf_hi(unsigned w) { return __uint_as_float(w & 0xffff0000u); }
template <int CTRL> DI float dpp_f(float v) { return __int_as_float(__builtin_amdgcn_update_dpp(0, __float_as_int(v), CTRL, 0xF, 0xF, true)); }
DI float wave_sum(float v) {
    v += dpp_f<0xB1>(v);
    v += dpp_f<0x4E>(v);
    v += dpp_f<0x141>(v);
    v += dpp_f<0x140>(v);
    const float s0 = __int_as_float(__builtin_amdgcn_readlane(__float_as_int(v), 0)), s1 = __int_as_float(__builtin_amdgcn_readlane(__float_as_int(v), 16));
    const float s2 = __int_as_float(__builtin_amdgcn_readlane(__float_as_int(v), 32)), s3 = __int_as_float(__builtin_amdgcn_readlane(__float_as_int(v), 48));
    return (s0 + s1) + (s2 + s3);
}
template <int CTRL> DI int dpp_i(int v) { return __builtin_amdgcn_update_dpp(0, v, CTRL, 0xF, 0xF, true); }
DI float xrow_sum(float v) {
    v += __shfl_xor(v, 16);
    auto rr = __builtin_amdgcn_permlane32_swap(__float_as_uint(v), __float_as_uint(v), false, false); return __uint_as_float(rr[0]) + __uint_as_float(rr[1]);
}
DI float reduce_scatter8(float (&v)[8], int lane) {
    float c4[4], d2[2];
    { const bool up = lane & 8;
#pragma unroll
      for (int i = 0; i < 4; ++i) { const float keep = up ? v[4 + i] : v[i], send = up ? v[i] : v[4 + i]; c4[i] = keep + dpp_f<0x140>(send); } }
    { const bool up = lane & 4;
#pragma unroll
      for (int i = 0; i < 2; ++i) { const float keep = up ? c4[2 + i] : c4[i], send = up ? c4[i] : c4[2 + i]; d2[i] = keep + dpp_f<0x141>(send); } }
    float e1; { const bool up = lane & 2; const float keep = up ? d2[1] : d2[0], send = up ? d2[0] : d2[1]; e1 = keep + dpp_f<0x4E>(send); }
    e1 += dpp_f<0xB1>(e1);
    return xrow_sum(e1);
}
DI float reduce_scatter16(float (&v)[16], int lane) {
    float a8[8], c4[4], d2[2];
    { const bool up = lane & 8;
#pragma unroll
      for (int i = 0; i < 8; ++i) { const float keep = up ? v[8 + i] : v[i], send = up ? v[i] : v[8 + i]; a8[i] = keep + dpp_f<0x140>(send); } }
    { const bool up = lane & 4;
#pragma unroll
      for (int i = 0; i < 4; ++i) { const float keep = up ? a8[4 + i] : a8[i], send = up ? a8[i] : a8[4 + i]; c4[i] = keep + dpp_f<0x141>(send); } }
    { const bool up = lane & 2;
#pragma unroll
      for (int i = 0; i < 2; ++i) { const float keep = up ? c4[2 + i] : c4[i], send = up ? c4[i] : c4[2 + i]; d2[i] = keep + dpp_f<0x4E>(send); } }
    float e1; { const bool up = lane & 1; const float keep = up ? d2[1] : d2[0], send = up ? d2[0] : d2[1]; e1 = keep + dpp_f<0xB1>(send); }
    return xrow_sum(e1);
}

DI float fast_exp(float x) { return __builtin_amdgcn_exp2f(x * 1.4426950408889634f); }
DI float sigmoidf_(float x) { return __builtin_amdgcn_rcpf(1.0f + fast_exp(-x)); }
#define LDS_WAIT() asm volatile("s_waitcnt lgkmcnt(0)" ::: "memory")
#define VM_WAIT() asm volatile("s_waitcnt vmcnt(0)" ::: "memory")

#define XB_TMO      128
#define XB_XCNT(j)  (256  + 64 * (j))
#define XB_XSUB(j)  (1280 + 64 * (j))
#define XB_XGEN(j)  (2304 + 64 * (j))
#define XB_TOP      3328
#define XB_TOPGEN   3392
#define XCD_BAR_WORDS 3456
#define XB_SPIN_CAP (1u << 22)
DI unsigned xb_ld(unsigned* p)              { return __hip_atomic_load(p, __ATOMIC_RELAXED, __HIP_MEMORY_SCOPE_AGENT); }
DI unsigned xb_add(unsigned* p, unsigned v) { return __hip_atomic_fetch_add(p, v, __ATOMIC_RELAXED, __HIP_MEMORY_SCOPE_AGENT); }
DI unsigned xb_xcc_id() { return (unsigned)__builtin_amdgcn_s_getreg((3 << 11) | 20) & 0xFu; }
#define XB_SPIN(cond, bar) do { unsigned _sp = 0; while (cond) { __builtin_amdgcn_s_sleep(1); \
    if ((++_sp & 255u) == 0u) { if (xb_ld(&(bar)[XB_TMO])) break; if (_sp > XB_SPIN_CAP) { atomicAdd(&(bar)[XB_TMO], 1u); break; } } } } while (0)
struct XcdBarrier { unsigned* bar; unsigned x; volatile LAS unsigned* st; };
DI XcdBarrier xcd_barrier_post(unsigned* bar, volatile LAS unsigned* st) {
    XcdBarrier b; b.bar = bar; b.x = xb_xcc_id(); b.st = st;
    if (threadIdx.x == 0) (void)xb_add(&bar[XB_XCNT(b.x)], 1u);
    return b;
}
DI void xcd_barrier_complete(unsigned* bar, unsigned x, unsigned& nloc, unsigned& nx) {
    const unsigned G = gridDim.x * gridDim.y * gridDim.z;
    unsigned sum, cnt, mine, sp = 0u;
    for (;;) {
        sum = 0u; cnt = 0u; mine = 0u;
#pragma unroll
        for (unsigned j = 0; j < 16; ++j) { const unsigned c = xb_ld(&bar[XB_XCNT(j)]); sum += c; cnt += (c > 0u) ? 1u : 0u; mine = (j == x) ? c : mine; }
        if (sum == G) break;
        __builtin_amdgcn_s_sleep(1);
        if ((++sp & 255u) == 0u) { if (xb_ld(&bar[XB_TMO])) break; if (sp > XB_SPIN_CAP) { atomicAdd(&bar[XB_TMO], 1u); break; } }
    }
    nloc = mine > 0u ? mine : 1u; nx = cnt > 0u ? cnt : 1u;
}
DI void xcd_barrier(const XcdBarrier& b) {
    asm volatile("s_waitcnt vmcnt(0)" ::: "memory");
    __syncthreads();
    if (threadIdx.x == 0) {
        unsigned* bar = b.bar; unsigned bx_ = b.x; asm volatile("" : "+s"(bar), "+s"(bx_));
        __builtin_amdgcn_s_waitcnt(0);
        unsigned nloc = b.st[0], nx = b.st[1];
        if (nloc == 0u) { xcd_barrier_complete(bar, bx_, nloc, nx); b.st[0] = nloc; b.st[1] = nx; }
        const unsigned old = xb_add(&bar[XB_XSUB(bx_)], 1u);
        const unsigned gen = old / nloc;
        if (old + 1u == (gen + 1u) * nloc) {
            __builtin_amdgcn_fence(__ATOMIC_RELEASE, "agent");
            asm volatile("s_waitcnt vmcnt(0)" ::: "memory");
            const unsigned og = xb_add(&bar[XB_TOP], 1u);
            const unsigned tg = og / nx;
            if (og + 1u == (tg + 1u) * nx) xb_add(&bar[XB_TOPGEN], 1u);
            else XB_SPIN(xb_ld(&bar[XB_TOPGEN]) == tg, bar);
            __builtin_amdgcn_fence(__ATOMIC_ACQUIRE, "agent");
            xb_add(&bar[XB_XGEN(bx_)], 1u);
            asm volatile("s_waitcnt vmcnt(0)" ::: "memory");
        } else {
            XB_SPIN(xb_ld(&bar[XB_XGEN(bx_)]) == gen, bar);
            __builtin_amdgcn_fence(__ATOMIC_ACQUIRE, "agent");
            asm volatile("s_waitcnt vmcnt(0)" ::: "memory");
        }
    }
    __syncthreads();
}

namespace pg8 {
constexpr int BM = 256, BK = 64, HALF = 128, HTB = HALF * BK * 2, STAGE_BYTES = 8 * HTB, NXCD = 8, WGM = 8;
__host__ __device__ __forceinline__ int lds_byte(int r, int c) { const int st = (r >> 4) * 2 + (c >> 5), rr = r & 15, cc = c & 31, ob = rr * 64 + cc * 2; return st * 1024 + (ob ^ (((ob >> 9) & 1) << 5)); }
__host__ __device__ __forceinline__ void stage_rc(int b, int& R, int& C) { const int st = b / 1024, sb = b % 1024, swz = sb ^ (((sb >> 9) & 1) << 5); R = (st >> 1) * 16 + swz / 64; C = (st & 1) * 32 + (swz % 64) / 2; }
__host__ __device__ __forceinline__ int perm32(int rho) { const int n = rho >> 4, i = rho & 15; return 8 * (i >> 2) + 4 * n + (i & 3); }

struct Unit { int pm, pn, e, r0, cnt; const char* a; const char* b; };

struct TileOrder {
    int nM, nN, nwg, G, c; const char* A; const char* Bt; size_t tstep, estride; const LAS unsigned char* texp; const LAS int* pstart; const LAS int* ecnt; const int* rowtok; bool gather; bool noepi = false;
    DI void init(const void* A_, const void* Bt_, int nM_, int nN_, int K, int G_, int c_, size_t estride_ = 0, const LAS unsigned char* texp_ = nullptr, const LAS int* pstart_ = nullptr, const LAS int* ecnt_ = nullptr,
                 const int* rowtok_ = nullptr, bool gather_ = false) {
        A = (const char*)A_; Bt = (const char*)Bt_; nM = nM_; nN = nN_; nwg = nM * nN; G = G_; c = c_; tstep = (size_t)BM * K * 2; estride = estride_; texp = texp_; pstart = pstart_; ecnt = ecnt_; rowtok = rowtok_; gather = gather_; }
    DI bool next(int i, Unit& u) const {
        const long L = (long)i * G + c; if (L >= nwg) return false;
        int wgid = (int)L; { const int q = nwg / NXCD, r = nwg % NXCD, xcd = wgid % NXCD, off = wgid / NXCD; wgid = (xcd < r ? xcd * (q + 1) : r * (q + 1) + (xcd - r) * q) + off; }
        int gid, rem;
        if (nN == 4) { gid = wgid / 32; rem = wgid % 32; } else if (nN == 8) { gid = wgid / 64; rem = wgid % 64; } else if (nN == 16) { gid = wgid / 128; rem = wgid % 128; } else if (nN == 24) { gid = wgid / 192; rem = wgid % 192; }
        else { const int nig = WGM * nN; gid = wgid / nig; rem = wgid % nig; }
        const int fm = gid * WGM, gsz = (nM - fm) < WGM ? (nM - fm) : WGM;
        if (gsz == WGM) { u.pm = fm + (rem & 7); u.pn = rem >> 3; } else { u.pm = fm + (rem % gsz); u.pn = rem / gsz; }
        u.e = texp ? __builtin_amdgcn_readfirstlane((int)texp[u.pm]) : 0;
        u.r0 = 0; u.cnt = 0;
        if (texp) { u.r0 = u.pm * BM - __builtin_amdgcn_readfirstlane(pstart[u.e]); u.cnt = __builtin_amdgcn_readfirstlane(ecnt[u.e]); }
        u.a = gather ? A : A + (size_t)u.pm * tstep; u.b = Bt + (size_t)u.e * estride + (size_t)u.pn * tstep; return true;
    }
};

template <class Epi, bool ALIGN_EPI = true, bool GATHER = false, bool FP8 = false>
DI void gemm_phase(LAS unsigned char* lds, const int K, const TileOrder& S, const Epi& E, int tid_in) {
    int tid = tid_in; asm volatile("" : "+v"(tid));
    const int wid = __builtin_amdgcn_readfirstlane(tid >> 6), lane = tid & 63, wr = wid >> 2, wc = wid & 3, fr = lane & 15, fq = lane >> 4;
    const int nt = K / BK;
    unsigned voffA[2], voffB[2];
#pragma unroll
    for (int i = 0; i < 2; ++i) { int R, C; stage_rc(tid * 16 + i * 8192, R, C); const int Rb = Epi::PERM ? ((R & ~31) + perm32(R & 31)) : R;
        voffA[i] = GATHER ? (unsigned)C * 2u : (unsigned)(R * K + C) * 2u; voffB[i] = (unsigned)(Rb * K + C) * 2u; }
    LAS unsigned* gslot = (LAS unsigned*)(lds + MISC_OFF + 8192) + tid * 2;
    unsigned gid[4] = {0u, 0u, 0u, 0u};
    auto gather_ld = [&](const Unit& u) {
        int t2 = tid; asm volatile("" : "+v"(t2)); int R0, R1, C_; stage_rc(t2 * 16, R0, C_); stage_rc(t2 * 16 + 8192, R1, C_);
#pragma unroll
        for (int h = 0; h < 2; ++h) { const int o0 = u.r0 + h * HALF + R0, o1 = u.r0 + h * HALF + R1;
            gid[2 * h] = o0 < u.cnt ? (unsigned)S.rowtok[(size_t)u.e * 32768 + o0] : 0u; gid[2 * h + 1] = o1 < u.cnt ? (unsigned)S.rowtok[(size_t)u.e * 32768 + o1] : 0u; } };
    auto gather_commit = [&](int nxt_) { gslot[nxt_ * 1024] = gid[0] | (gid[1] << 16); gslot[nxt_ * 1024 + 1] = gid[2] | (gid[3] << 16); };
    const size_t kstep = (size_t)(BK * 2);
    const size_t hstep = (size_t)HALF * K * 2;
    const unsigned ldsw = (unsigned)wid * 1024u;
    const int aoff = lds_byte(wr * 64 + fr, fq * 8), boff = lds_byte(wc * 32 + fr, fq * 8);
#define PG8_SA(b, h) (((b) * 2 + (h)) * HTB)
#define PG8_SB(b, h) ((4 + (b) * 2 + (h)) * HTB)
#define PG8_STAGE(bufoff, gbase, voff) do { _Pragma("unroll") for (int _i = 0; _i < 2; ++_i) \
        __builtin_amdgcn_global_load_lds((const unsigned*)((const char*)(gbase) + (voff)[_i]), (LAS unsigned*)(lds + (bufoff) + ldsw + _i * 8192), 16, 0, 0); } while (0)
#define PG8_STAGE_A(bufoff, h, gb, nx) do { if constexpr (GATHER) { const unsigned _w = gslot[((nx) ? 1024 : 0) + (h)]; unsigned _vo[2] = {(_w & 0xffffu) * (unsigned)(K * 2) + voffA[0], (_w >> 16) * (unsigned)(K * 2) + voffA[1]}; PG8_STAGE(bufoff, gb, _vo); } \
        else { PG8_STAGE(bufoff, (gb) + (h) * hstep, voffA); } } while (0)
#define PG8_LDA(dst, b, h) do { _Pragma("unroll") for (int m = 0; m < 4; ++m) { if constexpr (FP8) { dst##8[m].lo = *(const LAS v4i32*)(lds + PG8_SA(b, h) + aoff + m * 2048); dst##8[m].hi = *(const LAS v4i32*)(lds + PG8_SA(b, h) + aoff + m * 2048 + 1024); } \
        else { _Pragma("unroll") for (int k = 0; k < 2; ++k) dst[m][k] = *(const LAS bf16x8*)(lds + PG8_SA(b, h) + aoff + m * 2048 + k * 1024); } } } while (0)
#define PG8_LDB(dst, b, h) do { _Pragma("unroll") for (int n = 0; n < 2; ++n) { if constexpr (FP8) { dst##8[n].lo = *(const LAS v4i32*)(lds + PG8_SB(b, h) + boff + n * 2048); dst##8[n].hi = *(const LAS v4i32*)(lds + PG8_SB(b, h) + boff + n * 2048 + 1024); } \
        else { _Pragma("unroll") for (int k = 0; k < 2; ++k) dst[n][k] = *(const LAS bf16x8*)(lds + PG8_SB(b, h) + boff + n * 2048 + k * 1024); } } } while (0)
#define PG8_MMA(ai, bj, At, Bt) do { __builtin_amdgcn_s_setprio(1); _Pragma("unroll") for (int m = 0; m < 4; ++m) _Pragma("unroll") for (int n = 0; n < 2; ++n) { \
        if constexpr (FP8) { asm volatile("v_mfma_scale_f32_16x16x128_f8f6f4 %0, %1, %2, %0, %3, %3 op_sel_hi:[0,0,0]" : "+v"(acc[ai][bj][m][n]) : "v"(Bt##8[n]), "v"(At##8[m]), "v"(fp8_one)); } \
        else { _Pragma("unroll") for (int k = 0; k < 2; ++k) acc[ai][bj][m][n] = __builtin_amdgcn_mfma_f32_16x16x32_bf16(Bt[n][k], At[m][k], acc[ai][bj][m][n], 0, 0, 0); } } __builtin_amdgcn_s_setprio(0); } while (0)
#define PG8_WAIT_V(n) asm volatile("s_waitcnt vmcnt(" #n ")" ::: "memory")
#define PG8_WAIT_L(n) asm volatile("s_waitcnt lgkmcnt(" #n ")" ::: "memory")
#define PG8_BAR __builtin_amdgcn_s_barrier()
#define PG8_SCHED __builtin_amdgcn_sched_barrier(0)
    Unit cur, nxt; int ui = 0;
    if (!S.next(0, cur)) return;
    f32x4 acc[2][2][4][2];
#pragma unroll
    for (int a = 0; a < 2; ++a)
#pragma unroll
        for (int b = 0; b < 2; ++b)
#pragma unroll
            for (int m = 0; m < 4; ++m)
#pragma unroll
                for (int n = 0; n < 2; ++n) acc[a][b][m][n] = (f32x4){0.f, 0.f, 0.f, 0.f};
    const int fp8_one = 0x7F7F7F7F;
    bf16x8 At[4][2], B0[2][2], B1[2][2]; v8i32 At8[4], B08[2], B18[2];
    const char* cA = cur.a; const char* cB = cur.b;
    if constexpr (GATHER) { gather_ld(cur); gather_commit(0); }
    PG8_STAGE(PG8_SB(0, 0), cB, voffB); PG8_STAGE(PG8_SB(0, 1), cB + hstep, voffB); PG8_STAGE_A(PG8_SA(0, 0), 0, cA, false); PG8_STAGE_A(PG8_SA(0, 1), 1, cA, false);
    if (wr == 1) PG8_BAR;
    PG8_WAIT_V(2); PG8_BAR;
    PG8_STAGE(PG8_SB(1, 0), cB + kstep, voffB); PG8_STAGE_A(PG8_SA(1, 0), 0, cA + kstep, false); PG8_STAGE(PG8_SB(1, 1), cB + hstep + kstep, voffB);
    PG8_WAIT_V(6); PG8_BAR;
    for (;;) {
        const bool has_next = S.next(ui + 1, nxt);
        const char* nA = has_next ? nxt.a : cA; const char* nB = has_next ? nxt.b : cB;
        if constexpr (GATHER) { if (has_next) gather_ld(nxt); }
#pragma nounroll
        for (int t = 0; t < nt; t += 2) {
            if constexpr (Epi::HOOK) { if (t == Epi::HOOK_T0 || t == Epi::HOOK_T1) { PG8_SCHED; if constexpr (FP8) asm volatile("s_nop 15\n\ts_nop 15" ::: "memory"); E.hook(acc, cur, t, wr, wc, fr, fq); if constexpr (FP8) asm volatile("s_nop 7" ::: "memory"); PG8_SCHED; } }
            if constexpr (GATHER) { if (t == 2 && has_next) gather_commit(1); }
            const bool last = (t == nt - 2);
            const char* a1 = cA + (size_t)(t + 1) * kstep;
            const char* a2 = last ? nA : cA + (size_t)(t + 2) * kstep; const char* b2 = last ? nB : cB + (size_t)(t + 2) * kstep;
            const char* a3 = a2 + kstep; const char* b3 = b2 + kstep;
            const bool nx = last && has_next;
            PG8_LDB(B0, 0, 0); PG8_LDB(B1, 0, 1); PG8_SCHED; PG8_LDA(At, 0, 0); PG8_STAGE_A(PG8_SA(1, 1), 1, a1, false);
            PG8_WAIT_V(8); PG8_WAIT_L(0); PG8_BAR; PG8_MMA(0, 0, At, B0); PG8_MMA(0, 1, At, B1); PG8_BAR; PG8_SCHED;
            PG8_LDA(At, 0, 1); PG8_STAGE(PG8_SB(0, 0), b2, voffB); PG8_STAGE(PG8_SB(0, 1), b2 + hstep, voffB); PG8_STAGE_A(PG8_SA(0, 0), 0, a2, nx);
            PG8_WAIT_V(8); PG8_WAIT_L(0); PG8_BAR; PG8_MMA(1, 0, At, B0); PG8_MMA(1, 1, At, B1); PG8_BAR; PG8_SCHED;
            PG8_LDB(B0, 1, 0); PG8_LDB(B1, 1, 1); PG8_SCHED; PG8_LDA(At, 1, 0); PG8_STAGE_A(PG8_SA(0, 1), 1, a2, nx);
            PG8_WAIT_V(8); PG8_WAIT_L(0); PG8_BAR; PG8_MMA(0, 0, At, B0); PG8_MMA(0, 1, At, B1); PG8_BAR; PG8_SCHED;
            PG8_LDA(At, 1, 1); PG8_STAGE(PG8_SB(1, 0), b3, voffB); PG8_STAGE(PG8_SB(1, 1), b3 + hstep, voffB); PG8_STAGE_A(PG8_SA(1, 0), 0, a3, nx);
            PG8_WAIT_V(8); PG8_WAIT_L(0); PG8_BAR; PG8_MMA(1, 0, At, B0); PG8_MMA(1, 1, At, B1); PG8_BAR; PG8_SCHED;
        }
        if constexpr (ALIGN_EPI) { if (wr == 0) PG8_BAR; }
        if constexpr (FP8) asm volatile("s_nop 15\n\ts_nop 15" ::: "memory");
        if (!S.noepi) E(acc, cur, wr, wc, fr, fq);
        if (!has_next) break;
#pragma unroll
        for (int a = 0; a < 2; ++a)
#pragma unroll
            for (int b = 0; b < 2; ++b)
#pragma unroll
                for (int m = 0; m < 4; ++m)
#pragma unroll
                    for (int n = 0; n < 2; ++n) acc[a][b][m][n] = (f32x4){0.f, 0.f, 0.f, 0.f};
        cur = nxt; cA = nA; cB = nB; ++ui;
        if constexpr (GATHER) { gslot[0] = gslot[1024]; gslot[1] = gslot[1025]; }
        if constexpr (ALIGN_EPI) { if (wr == 1) PG8_BAR; }
    }
    PG8_WAIT_V(0);
    if constexpr (!ALIGN_EPI) { if (wr == 0) PG8_BAR; }
    PG8_BAR;
#undef PG8_SA
#undef PG8_SB
#undef PG8_STAGE
#undef PG8_STAGE_A
#undef PG8_LDA
#undef PG8_LDB
#undef PG8_MMA
#undef PG8_WAIT_V
#undef PG8_WAIT_L
#undef PG8_BAR
#undef PG8_SCHED
}
}

typedef f32x4 Acc[2][2][4][2];
constexpr float S_H = 16.0f, S_WGU = 1024.0f, S_ACT = 4.0f, S_WDN = 2048.0f, S_WIN = 1024.0f, S_MG = 128.0f, S_WOUT = 2048.0f, S_G = 64.0f, S_Y = 64.0f, S_O = 128.0f, S_WB = 256.0f;

struct EpiProj {
    static constexpr bool PERM = true, HOOK = false; static constexpr int HOOK_T0 = -1, HOOK_T1 = -1;
    bf16* O; const float* cosT; const float* sinT; bf16* KF; int pn_off; float dq; unsigned char* G8;
    DI void operator()(const Acc& acc, const pg8::Unit& u, int wr, int wc, int fr, int fq) const {
        const int pnt = u.pn + pn_off;
        const int row0 = u.pm * 256 + wr * 64 + fr, col0 = pnt * 256 + wc * 32 + 8 * fq;
        if (pnt < 8) {
            const int i0 = 16 * (wc & 1) + 4 * fq;
#pragma unroll
            for (int ai = 0; ai < 2; ++ai)
#pragma unroll
                for (int m = 0; m < 4; ++m) {
                    const int row = row0 + ai * 128 + m * 16;
                    const f32x4 cs = *(const f32x4*)(cosT + (size_t)row * 32 + i0), sn = *(const f32x4*)(sinT + (size_t)row * 32 + i0);
#pragma unroll
                    for (int bj = 0; bj < 2; ++bj) {
                        const int col = col0 + bj * 128; const float sc = ((QHEADS >> (col >> 6)) & 1u) ? C2 : 1.0f;
                        const f32x4 v0 = acc[ai][bj][m][0] * dq, v1 = acc[ai][bj][m][1] * dq;
                        u32x4 w;
                        w.x = cvt_pk((v0[0] * cs[0] - v0[1] * sn[0]) * sc, (v0[1] * cs[0] + v0[0] * sn[0]) * sc);
                        w.y = cvt_pk((v0[2] * cs[1] - v0[3] * sn[1]) * sc, (v0[3] * cs[1] + v0[2] * sn[1]) * sc);
                        w.z = cvt_pk((v1[0] * cs[2] - v1[1] * sn[2]) * sc, (v1[1] * cs[2] + v1[0] * sn[2]) * sc);
                        w.w = cvt_pk((v1[2] * cs[3] - v1[3] * sn[3]) * sc, (v1[3] * cs[3] + v1[2] * sn[3]) * sc);
                        int kh = -1;
                        if (col >= C_AK && col < C_BQ) kh = (col - C_AK) >> 6; else if (col >= C_BKS && col < C_CQ) kh = 4 + ((col - C_BKS) >> 6); else if (col >= C_CK) kh = 8 + ((col - C_CK) >> 6);
                        if (kh >= 0) {
                            const int sl = kh < 10 ? 0 : (kh < 12 ? 2 : 4);
                            const int t = row & (SEQ - 1), b = row >> 12, cls = t & ((1 << sl) - 1), mm = t >> sl, tile = cls * (128 >> sl) + (mm >> 5), d0 = col & 63;
                            *(u32x4*)(KF + ((size_t)((b * 14 + kh) * 128 + tile)) * 2048 + (d0 >> 4) * 512 + ((d0 >> 3) & 1) * 256 + (mm & 31) * 8) = w;
                        } else *(u32x4*)(O + (size_t)row * PP + col) = w;
                    }
                }
        } else {
            const bool sg = pnt >= 12;
#pragma unroll
            for (int ai = 0; ai < 2; ++ai)
#pragma unroll
                for (int m = 0; m < 4; ++m) {
                    const int row = row0 + ai * 128 + m * 16;
#pragma unroll
                    for (int bj = 0; bj < 2; ++bj) {
                        f32x4 v0 = acc[ai][bj][m][0] * dq, v1 = acc[ai][bj][m][1] * dq;
                        if (sg) {
#pragma unroll
                            for (int j = 0; j < 4; ++j) { v0[j] = sigmoidf_(v0[j]); v1[j] = sigmoidf_(v1[j]); }
                        }
                        if (sg) { u32x2 w; w.x = cvt_fp8x4(v0[0] * S_G, v0[1] * S_G, v0[2] * S_G, v0[3] * S_G); w.y = cvt_fp8x4(v1[0] * S_G, v1[1] * S_G, v1[2] * S_G, v1[3] * S_G);
                            *(u32x2*)(G8 + (size_t)row * 3072 + (col0 + bj * 128 - C_MG)) = w; }
                        else { u32x4 w; w.x = cvt_pk(v0[0], v0[1]); w.y = cvt_pk(v0[2], v0[3]); w.z = cvt_pk(v1[0], v1[1]); w.w = cvt_pk(v1[2], v1[3]);
                            *(u32x4*)(O + (size_t)row * PP + col0 + bj * 128) = w; }
                    }
                }
        }
    }
};

struct EpiBranchF {
    static constexpr bool PERM = true, HOOK = true; static constexpr int HOOK_T0 = 2, HOOK_T1 = 4;
    bf16* Mg; const unsigned char* G;
    DI static void unpack8(float (&f)[8], const u32x2 g) {
        f[0] = __builtin_amdgcn_cvt_f32_fp8((int)g.x, 0); f[1] = __builtin_amdgcn_cvt_f32_fp8((int)g.x, 1); f[2] = __builtin_amdgcn_cvt_f32_fp8((int)g.x, 2); f[3] = __builtin_amdgcn_cvt_f32_fp8((int)g.x, 3);
        f[4] = __builtin_amdgcn_cvt_f32_fp8((int)g.y, 0); f[5] = __builtin_amdgcn_cvt_f32_fp8((int)g.y, 1); f[6] = __builtin_amdgcn_cvt_f32_fp8((int)g.y, 2); f[7] = __builtin_amdgcn_cvt_f32_fp8((int)g.y, 3); }
    DI void hook(Acc& acc, const pg8::Unit& u, int t, int wr, int wc, int fr_in, int fq_in) const {
        int fr = fr_in, fq = fq_in; asm volatile("" : "+v"(fr), "+v"(fq));
        const int row0 = u.pm * 256 + wr * 64 + fr, col0 = u.pn * 256 + wc * 32 + 8 * fq;
        const unsigned char* gp = G + (t == HOOK_T0 ? 0 : 2 * DM);
        const int gnext = (t == HOOK_T0 ? 2 * DM : -DM);
#pragma unroll
        for (int ai = 0; ai < 2; ++ai) {
            u32x2 gpv[4][2], gnv[4][2];
#pragma unroll
            for (int m = 0; m < 4; ++m)
#pragma unroll
                for (int bj = 0; bj < 2; ++bj) { const unsigned char* p = gp + (size_t)(row0 + ai * 128 + m * 16) * 3072 + col0 + bj * 128; gpv[m][bj] = *(const u32x2*)p; gnv[m][bj] = *(const u32x2*)(p + gnext); }
#pragma unroll
            for (int m = 0; m < 4; ++m)
#pragma unroll
                for (int bj = 0; bj < 2; ++bj) { float gp8[8], gn8[8]; unpack8(gp8, gpv[m][bj]); unpack8(gn8, gnv[m][bj]);
#pragma unroll
                    for (int j = 0; j < 4; ++j) { acc[ai][bj][m][0][j] *= fmaxf(gp8[j], 1e-20f) * __builtin_amdgcn_rcpf(fmaxf(gn8[j], 1e-20f)); acc[ai][bj][m][1][j] *= fmaxf(gp8[4 + j], 1e-20f) * __builtin_amdgcn_rcpf(fmaxf(gn8[4 + j], 1e-20f)); } }
            asm volatile("" ::: "memory");
        }
    }
    DI void operator()(const Acc& acc, const pg8::Unit& u, int wr, int wc, int fr, int fq) const {
        const int row0 = u.pm * 256 + wr * 64 + fr, col0 = u.pn * 256 + wc * 32 + 8 * fq;
#pragma unroll
        for (int ai = 0; ai < 2; ++ai)
#pragma unroll
            for (int m = 0; m < 4; ++m) {
                const int row = row0 + ai * 128 + m * 16;
#pragma unroll
                for (int bj = 0; bj < 2; ++bj) {
                    const int col = col0 + bj * 128;
                    float g8[8]; unpack8(g8, *(const u32x2*)(G + DM + (size_t)row * 3072 + col));
#pragma unroll
                    for (int j = 0; j < 8; ++j) g8[j] = fmaxf(g8[j], 1e-20f) * (1.0f / (S_G * S_O * S_WB));
                    const f32x4 v0 = acc[ai][bj][m][0], v1 = acc[ai][bj][m][1];
                    u32x2 w; w.x = cvt_fp8x4(v0[0] * g8[0] * S_MG, v0[1] * g8[1] * S_MG, v0[2] * g8[2] * S_MG, v0[3] * g8[3] * S_MG);
                    w.y = cvt_fp8x4(v1[0] * g8[4] * S_MG, v1[1] * g8[5] * S_MG, v1[2] * g8[6] * S_MG, v1[3] * g8[7] * S_MG);
                    *(u32x2*)((unsigned char*)Mg + (size_t)row * DM + col) = w;
                }
            }
    }
};

struct EpiOut {
    static constexpr bool PERM = true, HOOK = false; static constexpr int HOOK_T0 = -1, HOOK_T1 = -1;
    bf16* Y;
    DI void operator()(const Acc& acc, const pg8::Unit& u, int wr, int wc, int fr, int fq) const {
        const int row0 = u.pm * 256 + wr * 64 + fr, col0 = u.pn * 256 + wc * 32 + 8 * fq;
#pragma unroll
        for (int ai = 0; ai < 2; ++ai)
#pragma unroll
            for (int m = 0; m < 4; ++m) {
                const int row = row0 + ai * 128 + m * 16;
#pragma unroll
                for (int bj = 0; bj < 2; ++bj) { constexpr float dq = 1.0f / (S_MG * S_WOUT); const f32x4 v0 = acc[ai][bj][m][0] * dq, v1 = acc[ai][bj][m][1] * dq;
                    u32x4 w; w.x = cvt_pk(v0[0], v0[1]); w.y = cvt_pk(v0[2], v0[3]); w.z = cvt_pk(v1[0], v1[1]); w.w = cvt_pk(v1[2], v1[3]);
                    *(u32x4*)(Y + (size_t)row * DM + col0 + bj * 128) = w; }
            }
    }
};

struct EpiGU {
    static constexpr bool PERM = true, HOOK = false; static constexpr int HOOK_T0 = -1, HOOK_T1 = -1;
    unsigned char* ACT; const float* bgu;
    DI void operator()(const Acc& acc, const pg8::Unit& u, int wr, int wc, int fr_in, int fq_in) const {
        int fr = fr_in, fq = fq_in; asm volatile("" : "+v"(fr), "+v"(fq));
        const int row0 = u.pm * 256 + wr * 64 + fr, col0 = u.pn * 256 + wc * 32 + 8 * fq;
        const float* bb = bgu + (size_t)u.e * 2048;
        constexpr float dq = 1.0f / (S_H * S_WGU);
        f32x4 bv[2][2];
#pragma unroll
        for (int bj = 0; bj < 2; ++bj)
#pragma unroll
            for (int n = 0; n < 2; ++n) bv[bj][n] = *(const f32x4*)(bb + col0 + bj * 128 + 4 * n);
#pragma unroll
        for (int ai = 0; ai < 2; ++ai)
#pragma unroll
            for (int m = 0; m < 4; ++m) {
                const int row = row0 + ai * 128 + m * 16;
#pragma unroll
                for (int bj = 0; bj < 2; ++bj) {
                    const f32x4 v0 = acc[ai][bj][m][0] * dq + bv[bj][0], v1 = acc[ai][bj][m][1] * dq + bv[bj][1];
                    const float gl[4] = {v0[0], v0[2], v1[0], v1[2]}, ln[4] = {v0[1], v0[3], v1[1], v1[3]};
                    float o[4];
#pragma unroll
                    for (int j = 0; j < 4; ++j) { const float g = fminf(gl[j], 7.0f), l = fminf(fmaxf(ln[j], -7.0f), 7.0f); o[j] = g * sigmoidf_(1.702f * g) * (l + 1.0f) * S_ACT; }
                    *(unsigned*)(ACT + (size_t)row * DM + ((col0 + bj * 128) >> 1)) = cvt_fp8x4(o[0], o[1], o[2], o[3]);
                }
            }
    }
};

struct EpiDN {
    static constexpr bool PERM = true, HOOK = false; static constexpr int HOOK_T0 = -1, HOOK_T1 = -1;
    bf16* YR; const float* bdn; const float* rowg;
    DI void operator()(const Acc& acc, const pg8::Unit& u, int wr, int wc, int fr_in, int fq_in) const {
        int fr = fr_in, fq = fq_in; asm volatile("" : "+v"(fr), "+v"(fq));
        const int row0 = u.pm * 256 + wr * 64 + fr, col0 = u.pn * 256 + wc * 32 + 8 * fq;
        const float* bb = bdn + (size_t)u.e * DM;
        f32x4 bv[2][2];
#pragma unroll
        for (int bj = 0; bj < 2; ++bj)
#pragma unroll
            for (int n = 0; n < 2; ++n) bv[bj][n] = *(const f32x4*)(bb + col0 + bj * 128 + 4 * n);
#pragma unroll
        for (int ai = 0; ai < 2; ++ai)
#pragma unroll
            for (int m = 0; m < 4; ++m) {
                const int row = row0 + ai * 128 + m * 16; const float g = rowg[(size_t)u.e * 32768 + u.r0 + (row - u.pm * 256)];
#pragma unroll
                for (int bj = 0; bj < 2; ++bj) {
                    constexpr float dq = 1.0f / (S_ACT * S_WDN);
                    const f32x4 v0 = (acc[ai][bj][m][0] * dq + bv[bj][0]) * g, v1 = (acc[ai][bj][m][1] * dq + bv[bj][1]) * g;
                    u32x2 w; w.x = cvt_fp8x4(v0[0] * S_Y, v0[1] * S_Y, v0[2] * S_Y, v0[3] * S_Y); w.y = cvt_fp8x4(v1[0] * S_Y, v1[1] * S_Y, v1[2] * S_Y, v1[3] * S_Y);
                    *(u32x2*)((unsigned char*)YR + (size_t)row * DM + col0 + bj * 128) = w;
                }
            }
    }
};

namespace att {
constexpr int VS = 192;
constexpr int VIMG = 32 * VS;
DI int crow(int r, int hi) { return (r & 3) + 8 * (r >> 2) + 4 * hi; }
DI float half_swap_other(float x, int hi) { auto rr = __builtin_amdgcn_permlane32_swap(__float_as_uint(x), __float_as_uint(x), false, false); return __uint_as_float(hi ? rr[0] : rr[1]); }
DI f32x2 half_both(float x) { auto rr = __builtin_amdgcn_permlane32_swap(__float_as_uint(x), __float_as_uint(x), false, false); return (f32x2){__uint_as_float(rr[0]), __uint_as_float(rr[1])}; }

struct KV { bf16x8 k[4]; u32x4 v[4]; };
template <bool CLAMP>
DI void kv_load(KV& t, const bf16* Ktile, const bf16* Vb, int pitch, int rbase, int rstride, int rmax, int lane) {
#pragma unroll
    for (int ks = 0; ks < 4; ++ks) t.k[ks] = *(const bf16x8*)(Ktile + ks * 512 + lane * 8);
    if constexpr (CLAMP) {
#pragma unroll
        for (int i = 0; i < 4; ++i) { int r = rbase + (8 * i + (lane >> 3)) * rstride; r = r < 0 ? 0 : (r > rmax ? rmax : r);
            t.v[i] = *(const u32x4*)(Vb + (size_t)r * pitch + 8 * (lane & 7)); }
    } else {
        const char* vt = (const char*)(Vb + (size_t)rbase * pitch);
#pragma unroll
        for (int i = 0; i < 4; ++i) t.v[i] = *(const u32x4*)(vt + (unsigned)(((8 * i + (lane >> 3)) * pitch + 8 * (lane & 7)) * 2));
    }
}
DI void kv_load_rows(KV& t, const bf16* Kb, const bf16* Vb, int pitch, int rbase, int rstride, int rmax, int lane) {
    { int r = rbase + (lane & 31) * rstride; r = r < 0 ? 0 : (r > rmax ? rmax : r);
      const bf16* p = Kb + (size_t)r * pitch + 8 * (lane >> 5);
#pragma unroll
      for (int ks = 0; ks < 4; ++ks) t.k[ks] = *(const bf16x8*)(p + 16 * ks); }
#pragma unroll
    for (int i = 0; i < 4; ++i) { int r = rbase + (8 * i + (lane >> 3)) * rstride; r = r < 0 ? 0 : (r > rmax ? rmax : r);
        t.v[i] = *(const u32x4*)(Vb + (size_t)r * pitch + 8 * (lane & 7)); }
}
DI void k_load(bf16x8 (&k)[4], const bf16* Kb, int pitch, int rbase, int rstride, int rmax, int lane) {
    int r = rbase + (lane & 31) * rstride; r = r < 0 ? 0 : (r > rmax ? rmax : r);
    const bf16* p = Kb + (size_t)r * pitch + 8 * (lane >> 5);
#pragma unroll
    for (int ks = 0; ks < 4; ++ks) k[ks] = *(const bf16x8*)(p + 16 * ks);
}
DI void v_store(LAS unsigned char* vimg, const KV& t, int lane) {
#pragma unroll
    for (int i = 0; i < 4; ++i) *(LAS u32x4*)(vimg + (8 * i + (lane >> 3)) * VS + 16 * (lane & 7)) = t.v[i];
}
DI s16x4 tr_read(const LAS unsigned char* p) { typedef short v4i16_t __attribute__((ext_vector_type(4))); return __builtin_bit_cast(s16x4, __builtin_amdgcn_ds_read_tr16_b64_v4i16((LAS v4i16_t*)p)); }
DI void vt_frags(bf16x8 (&vf)[2][2], const LAS unsigned char* vimg, int lane) {
    const int hi = lane >> 5, blk = (lane >> 4) & 1, q = (lane & 15) >> 2, p = lane & 3;
    const LAS unsigned char* base = vimg + (4 * hi + q) * VS + 2 * (16 * blk + 4 * p);
#pragma unroll
    for (int db = 0; db < 2; ++db)
#pragma unroll
        for (int s = 0; s < 2; ++s) { const s16x4 lo = tr_read(base + (16 * s) * VS + 64 * db), hh = tr_read(base + (16 * s + 8) * VS + 64 * db);
            vf[db][s] = (bf16x8){lo[0], lo[1], lo[2], lo[3], hh[0], hh[1], hh[2], hh[3]}; }
}
DI void q_load(bf16x8 (&q)[4], const bf16* Qrow  , int lane) {
#pragma unroll
    for (int ks = 0; ks < 4; ++ks) q[ks] = *(const bf16x8*)(Qrow + 16 * ks + 8 * (lane >> 5));
}
DI f32x16 zero16() { f32x16 z;
#pragma unroll
    for (int i = 0; i < 16; ++i) z[i] = 0.f; return z; }
DI f32x16 qk(const bf16x8 (&k)[4], const bf16x8 (&q)[4]) {
    f32x16 s = __builtin_amdgcn_mfma_f32_32x32x16_bf16(k[0], q[0], zero16(), 0, 0, 0);
    s = __builtin_amdgcn_mfma_f32_32x32x16_bf16(k[1], q[1], s, 0, 0, 0);
    s = __builtin_amdgcn_mfma_f32_32x32x16_bf16(k[2], q[2], s, 0, 0, 0);
    s = __builtin_amdgcn_mfma_f32_32x32x16_bf16(k[3], q[3], s, 0, 0, 0);
    return s;
}
DI void apply_mask(f32x16& s, int tq, int pbase, int pstride, unsigned W, unsigned DMK, bool sel, int hi) {
#pragma unroll
    for (int r = 0; r < 16; ++r) { const int kp = pbase + crow(r, hi) * pstride; const unsigned dt = (unsigned)(tq - kp);
        const bool ok = sel && dt <= W && (dt & DMK) == 0u && kp >= 0; s[r] = ok ? s[r] : -INFINITY; }
}
DI float max3f_(float a, float b, float c) { return __builtin_fmaxf(__builtin_fmaxf(a, b), c); }
DI float row_max(const f32x16& s) {
    const float m1 = max3f_(s[0], s[1], s[2]), m2 = max3f_(s[3], s[4], s[5]), m3 = max3f_(s[6], s[7], s[8]), m4 = max3f_(s[9], s[10], s[11]), m5 = max3f_(s[12], s[13], s[14]);
    const float a = max3f_(max3f_(m1, m2, m3), max3f_(m4, m5, s[15]), -INFINITY);
    const f32x2 b = half_both(a); return fmaxf(b.x, b.y);
}
struct Head { f32x16 o[2]; float m, l; };
DI void head_init(Head& h) { h.o[0] = zero16(); h.o[1] = zero16(); h.m = -1e30f; h.l = 0.f; }
DI void head_tile(Head& h, f32x16 s, const bf16x8 (&vf)[2][2]) {
    const float mn = fmaxf(h.m, row_max(s));
    const float al = __builtin_amdgcn_exp2f(h.m - mn);
    if (__any(mn > h.m)) {
#pragma unroll
        for (int r = 0; r < 16; ++r) { h.o[0][r] *= al; h.o[1][r] *= al; }
    }
    h.m = mn;
#pragma unroll
    for (int r = 0; r < 16; ++r) s[r] = __builtin_amdgcn_exp2f(s[r] - mn);
    const float sum = (((s[0] + s[1]) + (s[2] + s[3])) + ((s[4] + s[5]) + (s[6] + s[7]))) + (((s[8] + s[9]) + (s[10] + s[11])) + ((s[12] + s[13]) + (s[14] + s[15])));
    h.l = h.l * al + sum;
    u32x4 p0, p1;
    p0.x = cvt_pk(s[0], s[1]); p0.y = cvt_pk(s[2], s[3]); p0.z = cvt_pk(s[4], s[5]); p0.w = cvt_pk(s[6], s[7]);
    p1.x = cvt_pk(s[8], s[9]); p1.y = cvt_pk(s[10], s[11]); p1.z = cvt_pk(s[12], s[13]); p1.w = cvt_pk(s[14], s[15]);
    const bf16x8 pb0 = __builtin_bit_cast(bf16x8, p0), pb1 = __builtin_bit_cast(bf16x8, p1);
#pragma unroll
    for (int db = 0; db < 2; ++db) {
        h.o[db] = __builtin_amdgcn_mfma_f32_32x32x16_bf16(vf[db][0], pb0, h.o[db], 0, 0, 0);
        h.o[db] = __builtin_amdgcn_mfma_f32_32x32x16_bf16(vf[db][1], pb1, h.o[db], 0, 0, 0);
    }
}
DI void head_tile_v(Head& h, f32x16 s, const LAS unsigned char* vimg, int lane) {
    const float mn = fmaxf(h.m, row_max(s));
    const float al = __builtin_amdgcn_exp2f(h.m - mn);
    if (__any(mn > h.m)) {
#pragma unroll
        for (int r = 0; r < 16; ++r) { h.o[0][r] *= al; h.o[1][r] *= al; }
    }
    h.m = mn;
#pragma unroll
    for (int r = 0; r < 16; ++r) s[r] = __builtin_amdgcn_exp2f(s[r] - mn);
    const float sum = (((s[0] + s[1]) + (s[2] + s[3])) + ((s[4] + s[5]) + (s[6] + s[7]))) + (((s[8] + s[9]) + (s[10] + s[11])) + ((s[12] + s[13]) + (s[14] + s[15])));
    h.l = h.l * al + sum;
    u32x4 p0, p1;
    p0.x = cvt_pk(s[0], s[1]); p0.y = cvt_pk(s[2], s[3]); p0.z = cvt_pk(s[4], s[5]); p0.w = cvt_pk(s[6], s[7]);
    p1.x = cvt_pk(s[8], s[9]); p1.y = cvt_pk(s[10], s[11]); p1.z = cvt_pk(s[12], s[13]); p1.w = cvt_pk(s[14], s[15]);
    const bf16x8 pb0 = __builtin_bit_cast(bf16x8, p0), pb1 = __builtin_bit_cast(bf16x8, p1);
    const int hi = lane >> 5, blk = (lane >> 4) & 1, q = (lane & 15) >> 2, p = lane & 3;
    const LAS unsigned char* base = vimg + (4 * hi + q) * VS + 2 * (16 * blk + 4 * p);
#pragma unroll
    for (int db = 0; db < 2; ++db) {
        const s16x4 l0 = tr_read(base + 64 * db), h0 = tr_read(base + 8 * VS + 64 * db), l1 = tr_read(base + 16 * VS + 64 * db), h1 = tr_read(base + 24 * VS + 64 * db);
        const bf16x8 v0 = (bf16x8){l0[0], l0[1], l0[2], l0[3], h0[0], h0[1], h0[2], h0[3]}, v1 = (bf16x8){l1[0], l1[1], l1[2], l1[3], h1[0], h1[1], h1[2], h1[3]};
        h.o[db] = __builtin_amdgcn_mfma_f32_32x32x16_bf16(v0, pb0, h.o[db], 0, 0, 0);
        h.o[db] = __builtin_amdgcn_mfma_f32_32x32x16_bf16(v1, pb1, h.o[db], 0, 0, 0);
    }
}
DI void head_store(const Head& h, unsigned char* orow, float gate, bool accum, int hi) {
    const f32x2 lb = half_both(h.l); const float lt = lb.x + lb.y; const float sc = lt > 0.f ? gate * S_O / lt : 0.f;
#pragma unroll
    for (int db = 0; db < 2; ++db)
#pragma unroll
        for (int g = 0; g < 4; ++g) {
            unsigned char* p = orow + 32 * db + 8 * g + 4 * hi;
            float v0 = h.o[db][4 * g] * sc, v1 = h.o[db][4 * g + 1] * sc, v2 = h.o[db][4 * g + 2] * sc, v3 = h.o[db][4 * g + 3] * sc;
            if (accum) { const int o = *(const int*)p; v0 += __builtin_amdgcn_cvt_f32_fp8(o, 0); v1 += __builtin_amdgcn_cvt_f32_fp8(o, 1); v2 += __builtin_amdgcn_cvt_f32_fp8(o, 2); v3 += __builtin_amdgcn_cvt_f32_fp8(o, 3); }
            *(unsigned*)p = cvt_fp8x4(v0, v1, v2, v3);
        }
}
DI void apply_sel(f32x16& s, bool sel) {
#pragma unroll
    for (int r = 0; r < 16; ++r) s[r] = sel ? s[r] : -INFINITY;
}
template <int NH, bool QLDS, bool CLAMP, bool PERQ = false, class SelF>
DI void run_tiles(Head (&H)[NH], const bf16x8 (&qf)[NH][4], const LAS unsigned char* qimg  , const bf16* Kb  , int ktile0, const bf16* Vb, int pitch, int rmax,
                  int rbase0, int rstride, int pbase0, int pstride, int t0, int t1, int tq, int qmin, int qmax  , unsigned W, unsigned DMK, LAS unsigned char* vimg, int lane, SelF self) {
    const int hi = lane >> 5;
    auto anysel = [&](int tt) -> bool { if constexpr (PERQ) return __any(self(tt, 0) || self(tt, 1)); else return __any(self(tt)); };
    int ta = t0;
    while (ta < t1 && !anysel(ta)) ++ta;
    if (ta >= t1) return;
    auto next_tile = [&](int tc) -> int { int tn = tc + 1; while (tn < t1 && !anysel(tn)) ++tn; return tn; };
    auto load = [&](KV& kv, int tl) { const int tc = tl < t1 ? tl : t1 - 1;
        kv_load<CLAMP>(kv, Kb + (size_t)(ktile0 + tc) * 2048, Vb, pitch, rbase0 + 32 * tc * rstride, rstride, rmax, lane); };
    auto touch = [&](KV& kv) { asm volatile("" :: "v"(kv.k[0]), "v"(kv.k[1]), "v"(kv.k[2]), "v"(kv.k[3]), "v"(kv.v[0]), "v"(kv.v[1]), "v"(kv.v[2]), "v"(kv.v[3])); };
    auto body = [&](const KV& kv, int t) {
        v_store(vimg, kv, lane);
        const int pb = pbase0 + 32 * t * pstride;
        bf16x8 vf[2][2];
        if constexpr (NH == 1) vt_frags(vf, vimg, lane);
#pragma unroll
        for (int h = 0; h < NH; ++h) {
            const int qo = PERQ ? 32 * h : 0;
            bool sel; if constexpr (PERQ) sel = self(t, h); else sel = self(t);
            const bool full = (pb + 31 * pstride > qmin + qo) || ((unsigned)(qmax + qo - pb) > W) || (DMK != 0u) || (pb < 0);
            const bool selall = __all(sel);
            f32x16 s;
            if constexpr (QLDS) { bf16x8 q[4];
#pragma unroll
                for (int ks = 0; ks < 4; ++ks) q[ks] = *(const LAS bf16x8*)(qimg + h * 4096 + ks * 1024 + lane * 16);
                s = qk(kv.k, q); }
            else s = qk(kv.k, qf[h]);
            if (full) apply_mask(s, tq + qo, pb, pstride, W, DMK, sel, hi);
            else if (!selall) apply_sel(s, sel);
            if constexpr (NH == 1) head_tile(H[h], s, vf); else head_tile_v(H[h], s, vimg, lane);
        }
    };
    KV A, B;
    load(A, ta);
    for (;;) {
        int tb = next_tile(ta);
        touch(A); load(B, tb); body(A, ta); if (tb >= t1) break;
        ta = next_tile(tb);
        touch(B); load(A, ta); body(B, tb); if (ta >= t1) break;
    }
    touch(A); touch(B);
}
}

struct AttnCtx {
    const bf16* PROJ; const bf16* KF; const bf16* KM; const bf16* KC; const bf16* VC; const float* GL;
    unsigned char* OA; unsigned char* OB; unsigned char* OC; unsigned* SELM;
};
DI int opaque_v(int x) { asm volatile("" : "+v"(x)); return x; }
DI unsigned wave_pop(unsigned* q, int lane) {
    unsigned v = 0; if (lane == 0) v = __hip_atomic_fetch_add(q, 1u, __ATOMIC_RELAXED, __HIP_MEMORY_SCOPE_AGENT);
    return (unsigned)__builtin_amdgcn_readfirstlane((int)v);
}

DI void moba_unit(const AttnCtx& C, int b, int h, int t0, LAS unsigned char* vimg, int lane_in) {
    using namespace att;
    const int lane = opaque_v(lane_in);
    const int hi = lane >> 5, c = lane & 31, tq = t0 + c, own = t0 >> 8;
    const bf16* base = C.PROJ + (size_t)b * SEQ * PP;
    bf16x8 qf[2][4]; unsigned selm[2];
#pragma unroll
    for (int p = 0; p < 2; ++p) {
        q_load(qf[p], base + (size_t)(tq + 32 * p) * PP + C_AQ + h * 64, lane);
        selm[p] = 0u;
        if (own > 0) {
            bf16x8 kmf[4]; k_load(kmf, C.KM + (size_t)(b * 4 + h) * 32 * 64, 64, 0, 1, 31, lane);
            const f32x16 g = qk(kmf, qf[p]);
            float ga[16];
#pragma unroll
            for (int r = 0; r < 8; ++r) { const f32x2 bb = half_both(g[r]); ga[crow(r, 0)] = bb.x; ga[crow(r, 0) + 4] = bb.y; }
#pragma unroll
            for (int it = 0; it < 3; ++it) {
                float best = -INFINITY; int bi = -1;
#pragma unroll
                for (int j = 0; j < 16; ++j) { const bool ok = (j < own) && !((selm[p] >> j) & 1u) && (ga[j] > best); best = ok ? ga[j] : best; bi = ok ? j : bi; }
                if (bi >= 0) selm[p] |= 1u << bi;
            }
        }
    }
    Head H[2]; head_init(H[0]); head_init(H[1]);
    const bf16* Kb = C.KF + (size_t)((b * 14 + h) * 128) * 2048; const bf16* Vb = base + C_AV + h * 64;
    const int tl = ((t0 + 32) >> 5) + 1;
    const unsigned s0 = selm[0], s1 = selm[1];
    auto self = [&](int t, int p) -> bool { const int j = t >> 3; return (j >= own) || (((p ? s1 : s0) >> j) & 1u); };
    LAS unsigned char* qimg = vimg + VIMG;
#pragma unroll
    for (int p = 0; p < 2; ++p)
#pragma unroll
        for (int ks = 0; ks < 4; ++ks) *(LAS bf16x8*)(qimg + p * 4096 + ks * 1024 + lane * 16) = qf[p][ks];
    run_tiles<2, true, false, true>(H, qf, qimg, Kb, 0, Vb, PP, SEQ - 1, 0, 1, 0, 1, 0, tl, tq, t0, t0 + 31, 0x7fffffffu, 0u, vimg, lane, self);
    head_store(H[0], C.OA + (size_t)(b * SEQ + tq) * 1024 + h * 64, 1.0f, false, hi);
    head_store(H[1], C.OA + (size_t)(b * SEQ + tq + 32) * 1024 + h * 64, 1.0f, false, hi);
}

DI void nsa_cmp(const AttnCtx& C, int b, int g, int t0, LAS unsigned char* vimg, int lane_in) {
    using namespace att;
    const int lane = opaque_v(lane_in);
    const int hi = lane >> 5, c = lane & 31, tq = t0 + c, own = t0 >> 6;
    const bf16* base = C.PROJ + (size_t)b * SEQ * PP;
    const float* gl = C.GL + (size_t)(b * SEQ + tq) * NGATE + g * 9;
    unsigned char* orow = C.OB + (size_t)(b * SEQ + tq) * 1024 + g * 192;
    const bf16* Kc = C.KC + (size_t)(b * 2 + g) * 256 * 64; const bf16* Vc = C.VC + (size_t)(b * 2 + g) * 256 * 64;
    LAS float* impl = (LAS float*)(vimg + VIMG) + lane;
    const int ncv = (t0 >> 4) + 1;
    const int nct = ncv > 255 ? 8 : (ncv + 31) >> 5;
    float mx[3], il[3];
    {
        bf16x8 qf[3][4];
#pragma unroll
        for (int r = 0; r < 3; ++r) q_load(qf[r], base + (size_t)tq * PP + C_BQ + (g * 3 + r) * 64, lane);
        float ls[3];
#pragma unroll
        for (int r = 0; r < 3; ++r) { mx[r] = -1e30f; ls[r] = 0.f; }
#pragma nounroll
        for (int t = 0; t < nct; ++t) {
            bf16x8 kf[4]; k_load(kf, Kc, 64, 32 * t, 1, 255, lane);
#pragma unroll
            for (int r = 0; r < 3; ++r) {
                f32x16 s = qk(kf, qf[r]);
                apply_mask(s, tq, 16 * 32 * t + 31, 16, 0x7fffffffu, 0u, true, hi);
                const float mn = fmaxf(mx[r], row_max(s)); float sum = 0.f;
#pragma unroll
                for (int i = 0; i < 16; ++i) sum += __builtin_amdgcn_exp2f(s[i] - mn);
                ls[r] = ls[r] * __builtin_amdgcn_exp2f(mx[r] - mn) + sum; mx[r] = mn;
            }
        }
#pragma unroll
        for (int r = 0; r < 3; ++r) { const f32x2 lb = half_both(ls[r]); const float lt = lb.x + lb.y; il[r] = lt > 0.f ? 1.0f / lt : 0.f; }
    }
#pragma unroll
    for (int i = 0; i < 32; ++i) impl[i * 64] = 0.f;
#pragma unroll
    for (int r = 0; r < 3; ++r) {
        Head H; head_init(H);
        bf16x8 qb[4]; q_load(qb, base + (size_t)tq * PP + C_BQ + (g * 3 + r) * 64, lane);
        float carry = 0.f;
#pragma nounroll
        for (int t = 0; t < nct; ++t) {
            KV kv; kv_load_rows(kv, Kc, Vc, 64, 32 * t, 1, 255, lane);
            v_store(vimg, kv, lane);
            bf16x8 vf[2][2]; vt_frags(vf, vimg, lane);
            f32x16 s = qk(kv.k, qb);
            apply_mask(s, tq, 16 * 32 * t + 31, 16, 0x7fffffffu, 0u, true, hi);
#pragma unroll
            for (int i = 0; i < 16; ++i) s[i] = __builtin_amdgcn_exp2f(s[i] - mx[r]) * il[r];
            u32x4 p0, p1;
            p0.x = cvt_pk(s[0], s[1]); p0.y = cvt_pk(s[2], s[3]); p0.z = cvt_pk(s[4], s[5]); p0.w = cvt_pk(s[6], s[7]);
            p1.x = cvt_pk(s[8], s[9]); p1.y = cvt_pk(s[10], s[11]); p1.z = cvt_pk(s[12], s[13]); p1.w = cvt_pk(s[14], s[15]);
            const bf16x8 pb0 = __builtin_bit_cast(bf16x8, p0), pb1 = __builtin_bit_cast(bf16x8, p1);
#pragma unroll
            for (int db = 0; db < 2; ++db) {
                H.o[db] = __builtin_amdgcn_mfma_f32_32x32x16_bf16(vf[db][0], pb0, H.o[db], 0, 0, 0);
                H.o[db] = __builtin_amdgcn_mfma_f32_32x32x16_bf16(vf[db][1], pb1, H.o[db], 0, 0, 0);
            }
            float a[4], bq[4];
#pragma unroll
            for (int gq = 0; gq < 4; ++gq) { const f32x2 bb = half_both(s[4 * gq + 3]); a[gq] = bb.x; bq[gq] = bb.y; }
#pragma unroll
            for (int gq = 0; gq < 4; ++gq) {
                const float ext = hi ? a[gq] : (gq == 0 ? carry : bq[gq - 1]);
                impl[(4 * t + gq) * 64] += (s[4 * gq] + s[4 * gq + 1]) + (s[4 * gq + 2] + s[4 * gq + 3]) + ext;
            }
            carry = bq[3];
        }
        H.l = 0.5f;
        head_store(H, orow + r * 64, sigmoidf_(gl[r * 3 + 0]), false, hi);
    }
    unsigned m0, m1;
    if (own < 16) {
        const unsigned ne = (own >> 1) + 1, no = (own + 1) >> 1;
        m0 = ne >= 32 ? 0xffffffffu : ((1u << ne) - 1u); m1 = no >= 32 ? 0xffffffffu : ((1u << no) - 1u);
    } else {
        unsigned mine = 0u;
#pragma unroll 4
        for (int i = 0; i < 32; ++i) { const int mblk = 2 * i + hi; const bool forced = (mblk == 0) || (mblk == own) || (mblk == own - 1);
            const float v = impl[i * 64]; impl[i * 64] = mblk > own ? -INFINITY : (forced ? 1e6f : v); }
#pragma nounroll
        for (int it = 0; it < 16; ++it) {
            float best = -INFINITY; int bi = 0;
#pragma unroll 8
            for (int i = 0; i < 32; ++i) { const float v = impl[i * 64]; const bool ok = v > best; best = ok ? v : best; bi = ok ? i : bi; }
            const f32x2 bv = half_both(best); const f32x2 bx = half_both(__int_as_float(2 * bi + hi));
            const int i0 = __float_as_int(bx.x), i1 = __float_as_int(bx.y);
            const bool win0 = (bv.x > bv.y) || (bv.x == bv.y && i0 < i1);
            const bool me = hi ? !win0 : win0;
            const float wv = win0 ? bv.x : bv.y;
            if (me && wv > -INFINITY) { mine |= 1u << bi; impl[bi * 64] = -INFINITY; }
        }
        auto rr = __builtin_amdgcn_permlane32_swap(mine, mine, false, false); m0 = rr[0]; m1 = rr[1];
    }
    if (hi == 0) *(u32x2*)(C.SELM + ((size_t)(b * 2 + g) * SEQ + tq) * 2) = (u32x2){m0, m1};
}
DI void nsa_rest(const AttnCtx& C, int b, int g, int t0, int part, LAS unsigned char* vimg, int lane_in) {
    using namespace att;
    const int lane = opaque_v(lane_in);
    const int hi = lane >> 5, c = lane & 31, tq = t0 + c;
    const bf16* base = C.PROJ + (size_t)b * SEQ * PP;
    const float* gl = C.GL + (size_t)(b * SEQ + tq) * NGATE + g * 9;
    unsigned char* orow = C.OB + (size_t)(b * SEQ + tq) * 1024 + g * 192;
    const u32x2 mm_ = *(const u32x2*)(C.SELM + ((size_t)(b * 2 + g) * SEQ + tq) * 2); const unsigned m0 = mm_.x, m1 = mm_.y;
    {
        auto self = [&](int t) -> bool { const int mb = t >> 1; const unsigned w = (mb & 1) ? m1 : m0; return (w >> (mb >> 1)) & 1u; };
        auto allf = [&](int) -> bool { return true; };
        const int tl = (t0 >> 5) + 1, tf = (t0 - 511) < 0 ? 0 : ((t0 - 511) >> 5);
        const bf16* Ks = C.KF + (size_t)((b * 14 + 4 + g) * 128) * 2048; const bf16* Vs = base + C_BVS + g * 64; const bf16* Kw = C.KF + (size_t)((b * 14 + 6 + g) * 128) * 2048; const bf16* Vw = base + C_BVW + g * 64;
        LAS unsigned char* qimg = vimg + VIMG;
        if (part == 0) {
            bf16x8 q2[2][4];
#pragma unroll
            for (int r = 0; r < 2; ++r) { q_load(q2[r], base + (size_t)tq * PP + C_BQ + (g * 3 + r) * 64, lane);
#pragma unroll
                for (int ks = 0; ks < 4; ++ks) *(LAS bf16x8*)(qimg + r * 4096 + ks * 1024 + lane * 16) = q2[r][ks]; }
            { Head H[2]; head_init(H[0]); head_init(H[1]);
              run_tiles<2, true, false>(H, q2, qimg, Ks, 0, Vs, PP, SEQ - 1, 0, 1, 0, 1, 0, tl, tq, t0, t0 + 31, 0x7fffffffu, 0u, vimg, lane, self);
              head_store(H[0], orow, sigmoidf_(gl[1]), true, hi); head_store(H[1], orow + 64, sigmoidf_(gl[4]), true, hi); }
            { Head H[2]; head_init(H[0]); head_init(H[1]);
              run_tiles<2, true, false>(H, q2, qimg, Kw, 0, Vw, PP, SEQ - 1, 0, 1, 0, 1, tf, tl, tq, t0, t0 + 31, 511u, 0u, vimg, lane, allf);
              head_store(H[0], orow, sigmoidf_(gl[2]), true, hi); head_store(H[1], orow + 64, sigmoidf_(gl[5]), true, hi); }
        }
        if (part == 1) {
            bf16x8 q1[1][4]; q_load(q1[0], base + (size_t)tq * PP + C_BQ + (g * 3 + 2) * 64, lane);
            { Head H[1]; head_init(H[0]);
              run_tiles<1, false, false>(H, q1, nullptr, Ks, 0, Vs, PP, SEQ - 1, 0, 1, 0, 1, 0, tl, tq, t0, t0 + 31, 0x7fffffffu, 0u, vimg, lane, self);
              head_store(H[0], orow + 128, sigmoidf_(gl[7]), true, hi); }
            { Head H[1]; head_init(H[0]);
              run_tiles<1, false, false>(H, q1, nullptr, Kw, 0, Vw, PP, SEQ - 1, 0, 1, 0, 1, tf, tl, tq, t0, t0 + 31, 511u, 0u, vimg, lane, allf);
              head_store(H[0], orow + 128, sigmoidf_(gl[8]), true, hi); }
        }
    }
}
DI void dil_unit(const AttnCtx& C, int b, int hh, int rho, int lt, LAS unsigned char* vimg, int lane_in) {
    using namespace att;
    const int lane = opaque_v(lane_in);
    const int hi = lane >> 5, c = lane & 31;
    const int qmin = rho + 512 * lt, qmax = qmin + 496, tq = qmin + 16 * c;
    const bf16* base = C.PROJ + (size_t)b * SEQ * PP;
    Head H[1]; head_init(H[0]);
    auto self = [&](int) -> bool { return true; };
#pragma unroll
    for (int gi = 0; gi < 3; ++gi) {
        const int head = 2 * gi + hh; const int w = gi == 0 ? 128 : (gi == 1 ? 512 : 2048); const int st = gi == 0 ? 1 : (gi == 1 ? 4 : 16);
        bf16x8 qf[1][4]; q_load(qf[0], base + (size_t)tq * PP + C_CQ + head * 64, lane);
        const int sl = gi == 0 ? 0 : (gi == 1 ? 2 : 4), cls = rho & (st - 1);
        const int m0 = (512 * lt - w) >> sl;
        const int kb = cls + st * m0;
        const int nt = gi == 0 ? 20 : (gi == 1 ? 8 : 5);
        const int tf = m0 < 0 ? ((-m0) >> 5) : 0;
        const bf16* Kh = C.KF + (size_t)((b * 14 + 8 + head) * 128) * 2048;
        run_tiles<1, false, true>(H, qf, nullptr, Kh, cls * (128 >> sl) + (m0 >> 5), base + C_CV + head * 64, PP, SEQ - 1, kb, st, kb, st, tf, nt, tq, qmin, qmax, (unsigned)w, 0u, vimg, lane, self);
    }
    unsigned char* orow = C.OC + (size_t)(b * SEQ + tq) * 1024;
    head_store(H[0], orow + hh * 64, 1.0f, false, hi);
    if (hh == 0) {
#pragma unroll
        for (int i = 0; i < 4; ++i) { *(u32x4*)(orow + 128 + 16 * (i * 2 + hi)) = (u32x4){0u, 0u, 0u, 0u}; *(u32x4*)(orow + 640 + 16 * (i * 2 + hi)) = (u32x4){0u, 0u, 0u, 0u}; }
    }
}

DI void prep_km(const bf16* KF, bf16* KM, int item, int lane) {
    const int b = item >> 6, h = (item >> 4) & 3, blk = item & 15;
    const bf16* src = KF + ((size_t)((b * 14 + h) * 128 + 8 * blk)) * 2048 + (lane & 7) * 256 + (lane >> 3) * 8;
    float acc[8];
#pragma unroll
    for (int j = 0; j < 8; ++j) acc[j] = 0.f;
#pragma unroll 4
    for (int i = 0; i < 32; ++i) { const u32x4 w = *(const u32x4*)(src + (size_t)(i >> 2) * 2048 + (i & 3) * 64);
        acc[0] += bf_lo(w.x); acc[1] += bf_hi(w.x); acc[2] += bf_lo(w.y); acc[3] += bf_hi(w.y); acc[4] += bf_lo(w.z); acc[5] += bf_hi(w.z); acc[6] += bf_lo(w.w); acc[7] += bf_hi(w.w); }
#pragma unroll
    for (int j = 0; j < 8; ++j) { acc[j] += __shfl_xor(acc[j], 8); acc[j] += __shfl_xor(acc[j], 16); acc[j] += __shfl_xor(acc[j], 32); acc[j] *= (1.0f / 256.0f); }
    bf16* dst = KM + (size_t)((b * 4 + h) * 32) * 64;
    if (lane < 8) { u32x4 w; w.x = cvt_pk(acc[0], acc[1]); w.y = cvt_pk(acc[2], acc[3]); w.z = cvt_pk(acc[4], acc[5]); w.w = cvt_pk(acc[6], acc[7]); *(u32x4*)(dst + blk * 64 + 8 * lane) = w; }
    if (blk == 0) { *(u32x4*)(dst + 16 * 64 + 8 * lane) = (u32x4){0u, 0u, 0u, 0u}; *(u32x4*)(dst + 24 * 64 + 8 * lane) = (u32x4){0u, 0u, 0u, 0u}; }
}
DI void cmp_unit_wg(const bf16* PROJ, const bf16* W1T, const bf16* W2T, const float* b1p, bf16* OUT, int b, int g, int col0, int nt, LAS float* red, int wave, int lane) {
    using namespace att;
    const int hi = lane >> 5, c = lane & 31, kq = wave & 3, nh = wave >> 2;
    const int n = nt * 32 + c, ne = n > 254 ? 254 : n;
    const bf16* inb = PROJ + (size_t)(b * SEQ + 16 * ne) * PP + col0 + 8 * hi;
    const bf16* wa = W1T + (size_t)(64 * nh + c) * 2048 + 8 * hi;
    f32x16 acc[2]; acc[0] = zero16(); acc[1] = zero16();
#pragma unroll 4
    for (int kk = kq * 32; kk < kq * 32 + 32; ++kk) {
        const bf16x8 bf = *(const bf16x8*)(inb + (size_t)(kk >> 2) * PP + 16 * (kk & 3));
#pragma unroll
        for (int jb = 0; jb < 2; ++jb) { const bf16x8 af = *(const bf16x8*)(wa + (size_t)(32 * jb) * 2048 + 16 * kk); acc[jb] = __builtin_amdgcn_mfma_f32_32x32x16_bf16(af, bf, acc[jb], 0, 0, 0); }
    }
#pragma unroll
    for (int jb = 0; jb < 2; ++jb)
#pragma unroll
        for (int r = 0; r < 16; ++r) red[(((2 * nh + jb) * 4 + kq) * 16 + r) * 64 + lane] = acc[jb][r];
    __syncthreads();
    LAS float* red2 = red + 16384;
    if (wave < 4) {
        const int jb = wave; float hv[16];
#pragma unroll
        for (int r = 0; r < 16; ++r) { const LAS float* pp = red + ((jb * 4) * 16 + r) * 64 + lane; const float v4 = (pp[0] + pp[16 * 64]) + (pp[2 * 16 * 64] + pp[3 * 16 * 64]);
            const int j = 32 * jb + crow(r, hi); const float v = v4 + ((b1p[j] + b1p[128 + j]) + (b1p[256 + j] + b1p[384 + j])); hv[r] = v * sigmoidf_(v); }
        f32x16 o2[2]; o2[0] = zero16(); o2[1] = zero16();
#pragma unroll
        for (int s = 0; s < 2; ++s) {
            u32x4 p; p.x = cvt_pk(hv[8 * s], hv[8 * s + 1]); p.y = cvt_pk(hv[8 * s + 2], hv[8 * s + 3]); p.z = cvt_pk(hv[8 * s + 4], hv[8 * s + 5]); p.w = cvt_pk(hv[8 * s + 6], hv[8 * s + 7]);
            const bf16x8 pb = __builtin_bit_cast(bf16x8, p);
#pragma unroll
            for (int db = 0; db < 2; ++db) {
                const bf16* wp = W2T + (size_t)(32 * db + c) * 128 + 32 * jb + 16 * s + 4 * hi;
                const u32x2 lo = *(const u32x2*)wp, hh = *(const u32x2*)(wp + 8);
                const u32x4 a4 = {lo.x, lo.y, hh.x, hh.y};
                o2[db] = __builtin_amdgcn_mfma_f32_32x32x16_bf16(__builtin_bit_cast(bf16x8, a4), pb, o2[db], 0, 0, 0);
            }
        }
#pragma unroll
        for (int db = 0; db < 2; ++db)
#pragma unroll
            for (int r = 0; r < 16; ++r) red2[((jb * 2 + db) * 16 + r) * 64 + lane] = o2[db][r];
    }
    __syncthreads();
    if (wave == 0) {
        bf16* orow = OUT + (size_t)((b * 2 + g) * 256 + n) * 64;
#pragma unroll
        for (int db = 0; db < 2; ++db)
#pragma unroll
            for (int gq = 0; gq < 4; ++gq) { float v[4];
#pragma unroll
                for (int i = 0; i < 4; ++i) { const LAS float* pp = red2 + (db * 16 + 4 * gq + i) * 64 + lane; v[i] = (pp[0] + pp[2 * 16 * 64]) + (pp[4 * 16 * 64] + pp[6 * 16 * 64]); }
                u32x2 w; w.x = cvt_pk(v[0], v[1]); w.y = cvt_pk(v[2], v[3]); *(u32x2*)(orow + 32 * db + 8 * gq + 4 * hi) = w; }
    }
    __syncthreads();
}

struct Row { f32x4 v[4]; };
DI void row_load(Row& r, const float* p, int lane) {
#pragma unroll
    for (int j = 0; j < 4; ++j) r.v[j] = *(const f32x4*)(p + 256 * j + 4 * lane);
}
DI void row_store(const Row& r, float* p, int lane) {
#pragma unroll
    for (int j = 0; j < 4; ++j) *(f32x4*)(p + 256 * j + 4 * lane) = r.v[j];
}
DI void row_store_bf16(const Row& r, bf16* p, int lane) {
#pragma unroll
    for (int j = 0; j < 4; ++j) { u32x2 w; w.x = cvt_pk(r.v[j][0], r.v[j][1]); w.y = cvt_pk(r.v[j][2], r.v[j][3]); *(u32x2*)(p + 256 * j + 4 * lane) = w; }
}
DI void row_store_fp8(const Row& r, unsigned char* p, float sc, int lane) {
#pragma unroll
    for (int j = 0; j < 4; ++j) *(unsigned*)(p + 256 * j + 4 * lane) = cvt_fp8x4(r.v[j][0] * sc, r.v[j][1] * sc, r.v[j][2] * sc, r.v[j][3] * sc);
}
DI void row_ln(Row& r) {
    float s = 0.f;
#pragma unroll
    for (int j = 0; j < 4; ++j) s += (r.v[j][0] + r.v[j][1]) + (r.v[j][2] + r.v[j][3]);
    const float mean = wave_sum(s) * (1.0f / DM); float q = 0.f;
#pragma unroll
    for (int j = 0; j < 4; ++j) { r.v[j] = r.v[j] - mean; q += (r.v[j][0] * r.v[j][0] + r.v[j][1] * r.v[j][1]) + (r.v[j][2] * r.v[j][2] + r.v[j][3] * r.v[j][3]); }
    const float rstd = __builtin_amdgcn_rsqf(wave_sum(q) * (1.0f / DM) + LN_EPS);
#pragma unroll
    for (int j = 0; j < 4; ++j) r.v[j] = r.v[j] * rstd;
}
DI void row_affine(Row& r, const float* scale, const float* shift, float one, int lane) {
#pragma unroll
    for (int j = 0; j < 4; ++j) { const f32x4 a = *(const f32x4*)(scale + 256 * j + 4 * lane), bq = *(const f32x4*)(shift + 256 * j + 4 * lane); r.v[j] = r.v[j] * (a + one) + bq; }
}
DI float row_dot(const Row& r, const f32x4 (&w)[4]) {
    f32x4 a = r.v[0] * w[0];
#pragma unroll
    for (int j = 1; j < 4; ++j) a += r.v[j] * w[j];
    return (a[0] + a[1]) + (a[2] + a[3]); }
DI void wvec_lds(f32x4 (&w)[4], const LAS float* p) {
#pragma unroll
    for (int j = 0; j < 4; ++j) w[j] = *(const LAS f32x4*)(p + 256 * j);
}
#define WVEC_TOUCH(w) asm volatile("" :: "v"((w)[0]), "v"((w)[1]), "v"((w)[2]), "v"((w)[3]))
struct Vec { f32x4 v[4]; };
DI void vec_load(Vec& p, const float* src, int lane) {
#pragma unroll
    for (int j = 0; j < 4; ++j) p.v[j] = *(const f32x4*)(src + 256 * j + 4 * lane);
}
DI void row_affine_r(Row& r, const Vec& scale, const Vec& shift, float one) {
#pragma unroll
    for (int j = 0; j < 4; ++j) r.v[j] = r.v[j] * (scale.v[j] + one) + shift.v[j];
}
DI void row_affine_l(Row& r, const LAS float* scale, const LAS float* shift, float one, int lane) {
#pragma unroll
    for (int j = 0; j < 4; ++j) { const f32x4 a = *(const LAS f32x4*)(scale + 256 * j + 4 * lane), bq = *(const LAS f32x4*)(shift + 256 * j + 4 * lane); r.v[j] = r.v[j] * (a + one) + bq; }
}
DI void ln1_tail(Row& r, const LAS float* wg, bf16* hrow, unsigned char* h8row, float* glrow, int lane);
DI void ln1_row(Row& r  , const float* modb  , const LAS float* wg, bf16* hrow, unsigned char* h8row, float* glrow, int lane) {
    row_ln(r); row_affine(r, modb + DM, modb, 1.0f, lane);
    ln1_tail(r, wg, hrow, h8row, glrow, lane);
}
DI void ln1_tail(Row& r  , const LAS float* wg, bf16* hrow, unsigned char* h8row, float* glrow, int lane) {
    (void)hrow; row_store_fp8(r, h8row, S_H, lane);
    float gv[16], g16 = 0.f, g17 = 0.f;
    { f32x4 wa[4], wb[4]; const LAS float* wp = wg + 4 * lane; wvec_lds(wa, wp);
#pragma unroll
      for (int o = 0; o < NGATE; o += 2) {
          wvec_lds(wb, wp + (o + 1) * DM); asm volatile("" ::: "memory"); WVEC_TOUCH(wa);
          { const float s = row_dot(r, wa); if (o < 16) gv[o] = s; else g16 = s; }
          if (o + 2 < NGATE) wvec_lds(wa, wp + (o + 2) * DM);
          asm volatile("" ::: "memory"); WVEC_TOUCH(wb);
          { const float s = row_dot(r, wb); if (o + 1 < 16) gv[o + 1] = s; else g17 = s; } } }
    const float m16 = reduce_scatter16(gv, lane); g16 = wave_sum(g16); g17 = wave_sum(g17);
    if (lane < NGATE) glrow[lane] = lane < 16 ? m16 : (lane == 16 ? g16 : g17);
}
DI void lds_fill(LAS float* dst, const float* src, int nfloats, int tid) {
    for (int i = tid * 4; i < nfloats; i += 512 * 4) *(LAS f32x4*)(dst + i) = *(const f32x4*)(src + i);
}
DI int win_src(int n) {
    if (n < 2048) {
        int bm, bo;
        if (n < 256) { bm = C_AQ; bo = O_AQ; } else if (n < 512) { bm = C_AK; bo = O_AK; } else if (n < 896) { bm = C_BQ; bo = O_BQ; } else if (n < 1024) { bm = C_BKC; bo = O_BKC; }
        else if (n < 1152) { bm = C_BKS; bo = O_BKS; } else if (n < 1280) { bm = C_BKW; bo = O_BKW; } else if (n < 1664) { bm = C_CQ; bo = O_CQ; } else { bm = C_CK; bo = O_CK; }
        const int r = n - bm, cc = r & 63; return bo + (r & ~63) + (cc >> 1) + 32 * (cc & 1);
    }
    if (n < 2304) return O_AV + (n - C_AV);
    if (n < 2432) return O_BVC + (n - C_BVC);
    if (n < 2560) return O_BVS + (n - C_BVS);
    if (n < 2688) return O_BVW + (n - C_BVW);
    if (n < 3072) return O_CV + (n - C_CV);
    return O_MG + (n - C_MG);
}
DI int ileave(int c) { return (c & ~63) + ((c & 63) >> 1) + 32 * (c & 1); }
template <int KMODE, int NMODE>
DI void transpose_item(const float* W, int ldw, bf16* WT, int ldt, int k0, int n0, LAS float* scr, int lane) {
    const int nn = n0 + (lane & 31); const int ns = NMODE == 0 ? nn : (NMODE == 1 ? ileave(nn) : win_src(nn));
#pragma unroll 8
    for (int i = 0; i < 32; ++i) { const int kk = 2 * i + (lane >> 5); const int k = k0 + kk; const int ks = KMODE == 0 ? k : ileave(k); scr[kk * 33 + (lane & 31)] = W[(size_t)ks * ldw + ns]; }
    LDS_WAIT(); asm volatile("" ::: "memory");
    const int c = lane & 7;
#pragma unroll
    for (int j = 0; j < 4; ++j) { const int n = (lane >> 3) + 8 * j; const LAS float* s = scr + (8 * c) * 33 + n;
        u32x4 o; o.x = cvt_pk(s[0 * 33], s[1 * 33]); o.y = cvt_pk(s[2 * 33], s[3 * 33]); o.z = cvt_pk(s[4 * 33], s[5 * 33]); o.w = cvt_pk(s[6 * 33], s[7 * 33]);
        *(u32x4*)(WT + (size_t)(n0 + n) * ldt + k0 + 8 * c) = o; }
    LDS_WAIT(); asm volatile("" ::: "memory");
}

template <int NMODE = 0, int NOFF = 0>
DI void transpose_item_fp8(const float* W, int ldw, unsigned char* WT, int ldt, int k0, int n0, float sc, LAS float* scr, int lane) {
    const int nn = NMODE == 2 ? win_src(NOFF + n0 + (lane & 31)) : n0 + (lane & 31);
    float stg[32];
#pragma unroll
    for (int i = 0; i < 32; ++i) { const int kk = 2 * i + (lane >> 5); stg[i] = W[(size_t)(k0 + kk) * ldw + nn]; }
    asm volatile("" ::: "memory");
#pragma unroll
    for (int i = 0; i < 32; ++i) { const int kk = 2 * i + (lane >> 5); scr[kk * 33 + (lane & 31)] = stg[i]; }
    LDS_WAIT(); asm volatile("" ::: "memory");
    const int c = lane & 7;
#pragma unroll
    for (int j = 0; j < 4; ++j) { const int n = (lane >> 3) + 8 * j; const LAS float* s = scr + (8 * c) * 33 + n;
        u32x2 o; o.x = cvt_fp8x4(s[0 * 33] * sc, s[1 * 33] * sc, s[2 * 33] * sc, s[3 * 33] * sc); o.y = cvt_fp8x4(s[4 * 33] * sc, s[5 * 33] * sc, s[6 * 33] * sc, s[7 * 33] * sc);
        *(u32x2*)(WT + (size_t)(n0 + n) * ldt + k0 + 8 * c) = o; }
    LDS_WAIT(); asm volatile("" ::: "memory");
}

struct Args {
    const float* x; const float* c; const int* pos; const float* w_ada; const float* b_ada; const float* w_in;
    const float* w1k; const float* w2k; const float* pek; const float* w1v; const float* w2v; const float* pev;
    const float* wba; const float* wbb; const float* wbc; const float* wout; const float* ln1g; const float* ln1b;
    const float* rw; const float* rb; const float* wgu; const float* bgu; const float* wdn; const float* bdn; const float* ln2g; const float* ln2b;
    float* out; unsigned char* ws; int ph_lo, ph_hi, use_bar, qsel, amask, pad;
};
constexpr int NPH = 1 + 12 * DEPTH;

constexpr int I_IN = 16 * 192, I_BA = 4 * 32, I_BB = 6 * 32, I_BC = 2 * 32, I_BCZ = 64, I_OUT = 16 * 32, I_W1 = 32 * 4, I_W2 = 2 * 2, I_GU = 16 * 64 * NEXP, I_DN = 16 * 32 * NEXP;
constexpr int I_SM = I_IN + I_BA + I_BB + I_BC + I_BCZ + I_OUT + 2 * I_W1 + 2 * I_W2, I_L = I_SM + I_GU + I_DN;
constexpr int CW_CV = 16384;
static_assert(I_SM % 8 == 0 && (I_GU + I_DN) % 16 == 0, "conversion items are popped 8 / 16 at a time");
constexpr int CV_DEPTH = 4, CV_POP = 16, CV_WAVES = 1;
struct CvDesc { const float* rowb; unsigned char* dst; int ldw; float sc; };
DI CvDesc cv_desc(const Args& args, unsigned char* ws, int l, int j) {
    unsigned char* wl = ws + WS_WL + (size_t)l * WL_STRIDE; CvDesc d;
    if (j < I_GU) { const int e = j / 1024, q = j % 1024, k0 = 64 * (q / 64), n0 = 32 * (q % 64);
        d.rowb = args.wgu + ((size_t)l * NEXP + e) * DM * 2048 + (size_t)k0 * 2048 + n0; d.dst = wl + WL_GU + (size_t)e * 2048 * DM + (size_t)n0 * DM + k0; d.ldw = 2048; d.sc = S_WGU; }
    else { j -= I_GU; const int e = j / 512, q = j % 512, k0 = 64 * (q / 32), n0 = 32 * (q % 32);
        d.rowb = args.wdn + ((size_t)l * NEXP + e) * DM * DM + (size_t)k0 * DM + n0; d.dst = wl + WL_DN + (size_t)e * DM * DM + (size_t)n0 * DM + k0; d.ldw = DM; d.sc = S_WDN; }
    return d;
}
DI void cv_ld(float (&stg)[32], const CvDesc& d, int lane) {
    const int lo = (lane >> 5) * 32 * d.ldw + (lane & 31);
#pragma unroll
    for (int i = 0; i < 32; ++i) stg[i] = (d.rowb + (size_t)i * d.ldw)[lo];
}
DI void cv_st(const float (&stg)[32], const CvDesc& d, int lane) {
    const float sc = d.sc; u32x4 o0, o1;
    o0.x = cvt_fp8x4(stg[0] * sc, stg[1] * sc, stg[2] * sc, stg[3] * sc);     o0.y = cvt_fp8x4(stg[4] * sc, stg[5] * sc, stg[6] * sc, stg[7] * sc);
    o0.z = cvt_fp8x4(stg[8] * sc, stg[9] * sc, stg[10] * sc, stg[11] * sc);   o0.w = cvt_fp8x4(stg[12] * sc, stg[13] * sc, stg[14] * sc, stg[15] * sc);
    o1.x = cvt_fp8x4(stg[16] * sc, stg[17] * sc, stg[18] * sc, stg[19] * sc); o1.y = cvt_fp8x4(stg[20] * sc, stg[21] * sc, stg[22] * sc, stg[23] * sc);
    o1.z = cvt_fp8x4(stg[24] * sc, stg[25] * sc, stg[26] * sc, stg[27] * sc); o1.w = cvt_fp8x4(stg[28] * sc, stg[29] * sc, stg[30] * sc, stg[31] * sc);
    unsigned char* p = d.dst + (size_t)(lane & 31) * DM + (lane >> 5) * 32;
    *(u32x4*)p = o0; *(u32x4*)(p + 16) = o1;
}
DI void cv_item(const Args& args, unsigned char* ws, int l, int r, LAS float* scr, int lane) {
    unsigned char* wl = ws + WS_WL + (size_t)l * WL_STRIDE;
    if (r < I_IN) { const int n0 = 32 * (r % 192);
        transpose_item_fp8<2, 0>(args.w_in + (size_t)l * DM * IN_W, IN_W, wl + WL_IN, DM, 64 * (r / 192), n0, S_WIN, scr, lane);
        return; } r -= I_IN;
    if (r < I_BA) { transpose_item_fp8(args.wba + (size_t)l * 256 * DM, DM, wl + WL_BA, DM, 64 * (r / 32), 32 * (r % 32), S_WB, scr, lane); return; } r -= I_BA;
    if (r < I_BB) { transpose_item_fp8(args.wbb + (size_t)l * 384 * DM, DM, wl + WL_BA + 512, DM, 64 * (r / 32), 32 * (r % 32), S_WB, scr, lane); return; } r -= I_BB;
    if (r < I_BC) { transpose_item_fp8(args.wbc + (size_t)l * 128 * DM, DM, wl + WL_BA + 256, DM, 64 * (r / 32), 32 * (r % 32), S_WB, scr, lane); return; } r -= I_BC;
    if (r < I_BCZ) { unsigned char* z = wl + WL_BA;
#pragma unroll
        for (int q = 0; q < 4; ++q) { const int idx = q * 64 + lane, row = r * 16 + (idx >> 4), ch = idx & 15; *(u32x4*)(z + (size_t)row * DM + (ch < 8 ? 384 : 896 - 128) + 16 * ch) = (u32x4){0u, 0u, 0u, 0u}; }
        return; } r -= I_BCZ;
    if (r < I_OUT) { transpose_item_fp8(args.wout + (size_t)l * DM * DM, DM, wl + WL_OUT, DM, 64 * (r / 32), 32 * (r % 32), S_WOUT, scr, lane); return; } r -= I_OUT;
    if (r < I_W1) { transpose_item<1, 0>(args.w1k + (size_t)l * 2048 * 128, 128, (bf16*)(wl + WL_W1K), 2048, 64 * (r / 4), 32 * (r % 4), scr, lane); return; } r -= I_W1;
    if (r < I_W1) { transpose_item<0, 0>(args.w1v + (size_t)l * 2048 * 128, 128, (bf16*)(wl + WL_W1V), 2048, 64 * (r / 4), 32 * (r % 4), scr, lane); return; } r -= I_W1;
    if (r < I_W2) { transpose_item<0, 1>(args.w2k + (size_t)l * 128 * 64, 64, (bf16*)(wl + WL_W2K), 128, 64 * (r / 2), 32 * (r % 2), scr, lane); return; } r -= I_W2;
    if (r < I_W2) { transpose_item<0, 0>(args.w2v + (size_t)l * 128 * 64, 64, (bf16*)(wl + WL_W2V), 128, 64 * (r / 2), 32 * (r % 2), scr, lane); return; } r -= I_W2;
    if (r < I_GU) { const int e = r / 1024, q = r % 1024; transpose_item_fp8(args.wgu + ((size_t)l * NEXP + e) * DM * 2048, 2048, wl + WL_GU + (size_t)e * 2048 * DM, DM, 64 * (q / 64), 32 * (q % 64), S_WGU, scr, lane); return; } r -= I_GU;
    { const int e = r / 512, q = r % 512; transpose_item_fp8(args.wdn + ((size_t)l * NEXP + e) * DM * DM, DM, wl + WL_DN + (size_t)e * DM * DM, DM, 64 * (q / 32), 32 * (q % 32), S_WDN, scr, lane); }
}

__global__ void __launch_bounds__(512, 2) fwd(Args args) {
    extern __shared__ __attribute__((aligned(16))) unsigned char lds_raw[];
    LAS unsigned char* lds = (LAS unsigned char*)lds_raw;
    volatile LAS unsigned* MISC = (volatile LAS unsigned*)(lds + MISC_OFF);
    LAS int* L_PSTART = (LAS int*)(lds + MISC_OFF + 256);
    LAS unsigned char* L_TEXP = lds + MISC_OFF + 512;
    LAS int* L_CNT = (LAS int*)(lds + MISC_OFF + 1280);
    LAS int* L_BASE = (LAS int*)(lds + MISC_OFF + 1408);
    LAS int* L_E = (LAS int*)(lds + MISC_OFF + 2048);
    LAS float* L_G = (LAS float*)(lds + MISC_OFF + 4096);
    const int G = gridDim.x, bx = blockIdx.x, NGW = G * 8;
    const int wave_s = __builtin_amdgcn_readfirstlane((int)threadIdx.x >> 6);
    { const int t0_ = threadIdx.x; for (int u = t0_; u < 64; u += 512) MISC[u] = 0u; }
    __syncthreads();
    XcdBarrier bar; bar.bar = (unsigned*)(args.ws + WS_CTL) + CW_BAR; bar.x = 0; bar.st = MISC + 8;
    if (args.use_bar) bar = xcd_barrier_post((unsigned*)(args.ws + WS_CTL) + CW_BAR, MISC + 8);
    const int lo = args.ph_lo, hi_ph = args.ph_hi;
#define IN(k) (lo <= (k) && (k) < hi_ph)
#define EN(j) ((PHMASK >> (j)) & 1)
#define SEAM(k) do { if (IN(k) && IN((k) + 1)) xcd_barrier(bar); } while (0)
#define PH_BEGIN \
    unsigned ones_ = ~0u; asm volatile("" : "+s"(ones_)); int tid = wave_s * 64 + (int)__builtin_amdgcn_mbcnt_hi(ones_, __builtin_amdgcn_mbcnt_lo(ones_, 0u)); asm volatile("" : "+v"(tid)); const int lane = tid & 63, wave = __builtin_amdgcn_readfirstlane(tid >> 6), gw = bx * 8 + wave; (void)gw; (void)lane; \
    unsigned long long wsi_ = (unsigned long long)args.ws; asm volatile("" : "+s"(wsi_)); unsigned char* ws = (unsigned char*)(GAS unsigned char*)wsi_;   unsigned* ctl = (unsigned*)(ws + WS_CTL); (void)ctl; \
    float* MOD = (float*)(ws + WS_MOD); float* WGc = (float*)(ws + WS_WG); float* B1P = (float*)(ws + WS_B1); float* WRT = (float*)(ws + WS_WRT); \
    float* COS = (float*)(ws + WS_CS); float* SIN = COS + (size_t)NT * 32; \
    bf16* KM = (bf16*)(ws + WS_KM); bf16* KC = (bf16*)(ws + WS_KC); bf16* VC = (bf16*)(ws + WS_VC); float* GL = (float*)(ws + WS_GL); \
    int* TOKE = (int*)(ws + WS_TOKE); float* TOKG = (float*)(ws + WS_TOKG); int* TOKO = (int*)(ws + WS_TOKO); float* ROWG = (float*)(ws + WS_ROWG); \
    bf16* Hb = (bf16*)(ws + WS_H); bf16* PROJ = (bf16*)(ws + WS_PROJ); bf16* XG = PROJ; bf16* YR = PROJ; \
    unsigned char* OA = ws + WS_OA; unsigned char* OB = OA + 512; unsigned char* OC = OA + 256;     \
    bf16* MERGED = (bf16*)(ws + WS_MERGED); float* X = (float*)(ws + WS_X); bf16* ACT = (bf16*)(ws + WS_ACT); \
    unsigned char* wl = ws + WS_WL + (size_t)l * WL_STRIDE; const float* modl = MOD + (size_t)l * 8 * 6 * DM; const float* xin = (l == 0) ? args.x : X; \
    (void)WGc; (void)B1P; (void)WRT; (void)SIN; (void)KM; (void)KC; (void)VC; (void)GL; (void)TOKE; (void)TOKG; (void)TOKO; (void)ROWG; (void)Hb; (void)XG; (void)YR; (void)OA; (void)OB; (void)OC; (void)MERGED; (void)ACT; (void)wl; (void)modl; (void)xin;

    if (EN(12) && IN(0)) {
        const int l = 0; PH_BEGIN
        {
            LAS float* cond = (LAS float*)lds;
            LAS float* part = (LAS float*)(lds + 32768);
            bool have = false;
            for (int it = bx; it < DEPTH * 96; it += G) {
                if (!have) { for (int i = tid; i < 8 * DM; i += 512) { const float v = args.c[i]; cond[i] = v * sigmoidf_(v); } __syncthreads(); have = true; }
                const int l = it / 96, n = (it % 96) * 64 + lane;
                const float* W = args.w_ada + (size_t)l * DM * 6 * DM + n;
                float acc[8];
#pragma unroll
                for (int b = 0; b < 8; ++b) acc[b] = 0.f;
#pragma unroll 8
                for (int k = wave * 128; k < wave * 128 + 128; ++k) { const float w = W[(size_t)k * 6 * DM];
#pragma unroll
                    for (int b = 0; b < 8; ++b) acc[b] += cond[b * DM + k] * w; }
#pragma unroll
                for (int b = 0; b < 8; ++b) part[(wave * 8 + b) * 64 + lane] = acc[b];
                __syncthreads();
                { const int b = tid >> 6; float s = 0.f;
#pragma unroll
                  for (int w = 0; w < 8; ++w) s += part[(w * 8 + b) * 64 + lane];
                  MOD[((size_t)l * 8 + b) * 6 * DM + n] = s + args.b_ada[(size_t)l * 6 * DM + n]; }
                __syncthreads();
            }
            __syncthreads();
        }
        {
            LAS float* part = (LAS float*)lds;
            for (int it = bx; it < DEPTH * 2 * 4; it += G) {
                const int l = it >> 3, kv = (it >> 2) & 1, kq = it & 3, j = tid & 127, sl = tid >> 7;
                const float* w1 = (kv ? args.w1v : args.w1k) + (size_t)l * 2048 * 128; const float* pe = (kv ? args.pev : args.pek) + (size_t)l * 2048;
                float s = 0.f;
#pragma unroll 8
                for (int k = kq * 512 + sl * 128; k < kq * 512 + sl * 128 + 128; ++k) s += pe[k] * w1[(size_t)k * 128 + j];
                part[sl * 128 + j] = s; __syncthreads();
                if (tid < 128) B1P[(size_t)((l * 2 + kv) * 4 + kq) * 128 + tid] = (part[tid] + part[128 + tid]) + (part[256 + tid] + part[384 + tid]);
                __syncthreads();
            }
        }
        for (size_t i = (size_t)bx * 512 + tid; i < (size_t)NT * 32; i += (size_t)G * 512) {
            const int tok = (int)(i >> 5), fi = (int)(i & 31);
            const float invf = __builtin_amdgcn_exp2f(-(float)fi * (13.287712379549449f / 32.0f));
            const double ang = (double)args.pos[tok] * (double)invf * 0.15915494309189535;
            const float fr = (float)(ang - floor(ang));
            COS[i] = __builtin_amdgcn_cosf(fr); SIN[i] = __builtin_amdgcn_sinf(fr);
        }
        for (int i = bx * 512 + tid; i < DEPTH * NGATE * DM; i += G * 512) { const int l = i / (NGATE * DM), o = (i / DM) % NGATE, k = i % DM; WGc[i] = args.w_in[((size_t)l * DM + k) * IN_W + O_BG + o]; }
        for (int i = bx * 512 + tid; i < DEPTH * NEXP * DM; i += G * 512) { const int l = i / (NEXP * DM), e = (i / DM) % NEXP, k = i % DM; WRT[i] = args.rw[((size_t)l * DM + k) * NEXP + e]; }
        {
            LAS float* scr = (LAS float*)(lds + wave * 16384);
            for (int it = gw; it < I_SM; it += NGW) cv_item(args, ws, 0, it, scr, lane);
        }
    }
    SEAM(0);

#pragma nounroll
    for (int l = 0; l < DEPTH; ++l) {
        const int P = 1 + 12 * l;

        if (EN(0) && IN(P + 0) && l == 0) {
            PH_BEGIN
            LAS float* wg = (LAS float*)lds; lds_fill(wg, WGc + (size_t)l * NGATE * DM, NGATE * DM, tid); __syncthreads();
            const int rpw = NT / NGW;
#pragma nounroll
            for (int i = 0; i < rpw; i += 2) { const int row = gw * rpw + i;
                Row r0, r1; row_load(r0, xin + (size_t)row * DM, lane); row_load(r1, xin + (size_t)(row + 1) * DM, lane);
                ln1_row(r0, modl + (size_t)(row / SEQ) * 6 * DM, wg, Hb + (size_t)row * DM, ws + WS_H8 + (size_t)row * DM, GL + (size_t)row * NGATE, lane);
                ln1_row(r1, modl + (size_t)((row + 1) / SEQ) * 6 * DM, wg, Hb + (size_t)(row + 1) * DM, ws + WS_H8 + (size_t)(row + 1) * DM, GL + (size_t)(row + 1) * NGATE, lane); }
            __syncthreads();
        }
        SEAM(P + 0);

        if (EN(1) && IN(P + 1)) {
            PH_BEGIN
            pg8::TileOrder S; S.init(ws + WS_H8, wl + WL_IN, NT / 256, 24, DM / 2, G, bx);
            S.noepi = args.qsel == 2;
            EpiProj E{PROJ, COS, SIN, (bf16*)(ws + WS_KF), 0, 1.0f / (S_H * S_WIN), ws + WS_G8};
            pg8::gemm_phase<EpiProj, true, false, true>(lds, DM / 2, S, E, tid);
        }
        SEAM(P + 1);

        if (EN(2) && IN(P + 2)) {
            PH_BEGIN
            for (int it = bx; it < 256; it += G) { const int b = it >> 5, g = (it >> 4) & 1, kv = (it >> 3) & 1, nt = it & 7;
                if (kv == 0) cmp_unit_wg(PROJ, (const bf16*)(wl + WL_W1K), (const bf16*)(wl + WL_W2K), B1P + (size_t)(l * 2 + 0) * 512, KC, b, g, C_BKC + g * 64, nt, (LAS float*)lds, wave, lane);
                else         cmp_unit_wg(PROJ, (const bf16*)(wl + WL_W1V), (const bf16*)(wl + WL_W2V), B1P + (size_t)(l * 2 + 1) * 512, VC, b, g, C_BVC + g * 64, nt, (LAS float*)lds, wave, lane); }
            for (int it = gw; it < 512; it += NGW) prep_km((const bf16*)(ws + WS_KF), KM, it, lane);
        }
        SEAM(P + 2);

        if (EN(3) && IN(P + 3)) {
            PH_BEGIN
            const AttnCtx C{PROJ, (const bf16*)(ws + WS_KF), KM, KC, VC, GL, OA, OB, OC, (unsigned*)(ws + WS_SELM)};
            LAS unsigned char* vimg = lds + wave * 16384;
            unsigned* qb = ctl + CW_Q + (((args.qsel != 0) * 2 + l) * 4) * 8 * 64;
            for (int xo = 0; xo < 8; ++xo) { const int x = (bx + xo) & 7; unsigned* q = qb + (0 * 8 + x) * 64;
                for (;;) { const unsigned u = wave_pop(q, lane); if (u >= 256u) break;
                    const int ci = u & 7, bg = 2 * x + ((u >> 3) & 1), cg = u >> 4; nsa_cmp(C, bg >> 1, bg & 1, (127 - (cg * 8 + ci)) * 32, vimg, lane); } }
        }
        SEAM(P + 3);

        if (EN(4) && IN(P + 4)) {
            PH_BEGIN
            const AttnCtx C{PROJ, (const bf16*)(ws + WS_KF), KM, KC, VC, GL, OA, OB, OC, (unsigned*)(ws + WS_SELM)};
            LAS unsigned char* vimg = lds + wave * 16384;
            unsigned* qb = ctl + CW_Q + (((args.qsel != 0) * 2 + l) * 4) * 8 * 64;
            {
                MISC[32 + wave] = (unsigned)__builtin_amdgcn_s_getreg((1 << 11) | (4 << 6) | 4) & 3u;
                __syncthreads();
                const unsigned my_simd = MISC[32 + wave]; int rank = 0;
                for (int w = 0; w < wave; ++w) rank += (MISC[32 + w] == my_simd) ? 1 : 0;
                if (__builtin_amdgcn_readfirstlane(rank) == 0 && __builtin_amdgcn_readfirstlane((int)my_simd) < CV_WAVES) {
                    unsigned* cq = ctl + CW_CV + l * 64;
                    for (;;) { const int base = CV_POP * (int)wave_pop(cq, lane); if (base >= I_GU + I_DN) break;
#pragma nounroll
                        for (int g = 0; g < CV_POP; g += CV_DEPTH) {
                            float stg[CV_DEPTH][32]; CvDesc d[CV_DEPTH];
#pragma unroll
                            for (int t = 0; t < CV_DEPTH; ++t) { d[t] = cv_desc(args, ws, l, base + g + t); cv_ld(stg[t], d[t], lane); }
                            asm volatile("" ::: "memory");
#pragma unroll
                            for (int t = 0; t < CV_DEPTH; ++t) cv_st(stg[t], d[t], lane);
                        } }
                    if (l + 1 < DEPTH) { LAS float* scr = (LAS float*)(lds + wave * 16384);
                        for (;;) { const int base = 8 * (int)wave_pop(cq + 32, lane); if (base >= I_SM) break;
#pragma nounroll
                            for (int t = 0; t < 8; ++t) cv_item(args, ws, l + 1, base + t, scr, lane); } }
                }
            }
            if (args.amask & 1) for (int xo = 0; xo < 8; ++xo) { const int x = (bx + xo) & 7; unsigned* q = qb + (1 * 8 + x) * 64;
                for (;;) { const unsigned u = wave_pop(q, lane); if (u >= 512u) break;
                    const int ci = u & 7, part = (u >> 3) & 1, bg = 2 * x + ((u >> 4) & 1), cg = u >> 5; nsa_rest(C, bg >> 1, bg & 1, (127 - (cg * 8 + ci)) * 32, part, vimg, lane); } }
            if (args.amask & 2) for (int xo = 0; xo < 8; ++xo) { const int x = (bx + xo) & 7; unsigned* q = qb + (2 * 8 + x) * 64;
                for (;;) { const unsigned u = wave_pop(q, lane); if (u >= 256u) break;
                    const int ci = u & 7, bh = 4 * x + ((u >> 3) & 3), cg = u >> 5; moba_unit(C, bh >> 2, bh & 3, (63 - (cg * 8 + ci)) * 64, vimg, lane); } }
            if (args.amask & 4) for (int xo = 0; xo < 8; ++xo) { const int x = (bx + xo) & 7; unsigned* q = qb + (3 * 8 + x) * 64;
                for (;;) { const unsigned u = wave_pop(q, lane); if (u >= 256u) break;
                    const int ci = u & 7, bh = 2 * x + ((u >> 3) & 1), r2 = (u >> 4) & 1, lt = 7 - (int)(u >> 5); dil_unit(C, bh >> 1, bh & 1, r2 * 8 + ci, lt, vimg, lane); } }
        }
        SEAM(P + 4);

        if (EN(5) && IN(P + 5)) {
            PH_BEGIN
            pg8::TileOrder S; S.init(OA, wl + WL_BA, NT / 256, 4, DM / 2, G, bx); EpiBranchF E{MERGED, ws + WS_G8};
            pg8::gemm_phase<EpiBranchF, true, false, true>(lds, DM / 2, S, E, tid);
        }
        SEAM(P + 5);

        if (EN(6) && IN(P + 6)) {
            PH_BEGIN
            pg8::TileOrder S; S.init(MERGED, wl + WL_OUT, NT / 256, 4, DM / 2, G, bx);
            EpiOut E{PROJ};
            pg8::gemm_phase<EpiOut, true, false, true>(lds, DM / 2, S, E, tid);
        }
        SEAM(P + 6);

        if (EN(7) && IN(P + 7)) {
            PH_BEGIN
            LAS float* wr = (LAS float*)lds; lds_fill(wr, WRT + (size_t)l * NEXP * DM, NEXP * DM, tid);
            if (tid < 32) L_CNT[tid] = 0;
            LAS float* plg = (LAS float*)(lds + MISC_OFF + 6144); LAS float* plb = plg + DM; LAS float* prb = plb + DM;
            if (tid < NEXP) prb[tid] = args.rb[(size_t)l * NEXP + tid];
            for (int i = tid * 4; i < 2 * DM; i += 512 * 4) *(LAS f32x4*)(plg + i) = *(const f32x4*)(i < DM ? args.ln1g + (size_t)l * DM + i : args.ln1b + (size_t)l * DM + (i - DM));
            __syncthreads();
            const int RPW = NT / G, RPV = RPW / 8;
            const bool dry = args.qsel != 0;
            bf16* Xo = dry ? (bf16*)ACT : (bf16*)X; unsigned char* Ho = dry ? ((unsigned char*)ACT + 136 * MiB) : (ws + WS_H8);
            struct PR { u32x4 x0[4], x1[4]; u32x2 y0[4], y1[4]; };
            const bf16* Yb = PROJ;
            struct PP { Vec g1, sc, sh; };
            auto pp_load = [&](PP& p, int i) { const int row0 = bx * RPW + wave * RPV + i; const float* modb = modl + (size_t)(row0 / SEQ) * 6 * DM;
                vec_load(p.g1, modb + 2 * DM, lane); vec_load(p.sc, modb + 4 * DM, lane); vec_load(p.sh, modb + 3 * DM, lane); };
            auto pair_body = [&](PR& f, const PP& pp, int i) {
                const int lr0 = wave * RPV + i, row0 = bx * RPW + lr0;
                Row r0, r1;
#pragma unroll
                for (int j = 0; j < 4; ++j) { const u32x4 a = f.x0[j], b = f.x1[j];
                    if (l == 0) { r0.v[j] = (f32x4){__uint_as_float(a.x), __uint_as_float(a.y), __uint_as_float(a.z), __uint_as_float(a.w)}; r1.v[j] = (f32x4){__uint_as_float(b.x), __uint_as_float(b.y), __uint_as_float(b.z), __uint_as_float(b.w)}; }
                    else { r0.v[j] = (f32x4){bf_lo(a.x), bf_hi(a.x), bf_lo(a.y), bf_hi(a.y)}; r1.v[j] = (f32x4){bf_lo(b.x), bf_hi(b.x), bf_lo(b.y), bf_hi(b.y)}; } }
#pragma unroll
                for (int j = 0; j < 4; ++j) { const f32x4 g1v = pp.g1.v[j]; const u32x2 ya = f.y0[j], yb = f.y1[j];
                    r0.v[j] = r0.v[j] * ALPHA + g1v * (f32x4){bf_lo(ya.x), bf_hi(ya.x), bf_lo(ya.y), bf_hi(ya.y)}; r1.v[j] = r1.v[j] * ALPHA + g1v * (f32x4){bf_lo(yb.x), bf_hi(yb.x), bf_lo(yb.y), bf_hi(yb.y)}; }
                row_ln(r0); row_affine_l(r0, plg, plb, 0.0f, lane); row_store_bf16(r0, Xo + (size_t)row0 * DM, lane);
                row_ln(r1); row_affine_l(r1, plg, plb, 0.0f, lane); row_store_bf16(r1, Xo + (size_t)(row0 + 1) * DM, lane);
                row_ln(r0); row_affine_r(r0, pp.sc, pp.sh, 1.0f); row_store_fp8(r0, Ho + (size_t)row0 * DM, S_H, lane);
                row_ln(r1); row_affine_r(r1, pp.sc, pp.sh, 1.0f); row_store_fp8(r1, Ho + (size_t)(row0 + 1) * DM, S_H, lane);
                const int sub = (lane >> 1) & 7;
                float lg[2][4];
#pragma unroll
                for (int cch = 0; cch < 4; ++cch) { lg[0][cch] = 0.f; lg[1][cch] = 0.f; }
#pragma nounroll
                for (int cch = 0; cch < 4; ++cch) {
                    float a0[8], a1[8];
                    const LAS float* wp = wr + (cch * 8) * DM + 4 * lane;
                    f32x4 wa[4], wb[4]; wvec_lds(wa, wp);
#pragma unroll
                    for (int e8 = 0; e8 < 8; e8 += 2) {
                        wvec_lds(wb, wp + (e8 + 1) * DM); asm volatile("" ::: "memory"); WVEC_TOUCH(wa);
                        a0[e8] = row_dot(r0, wa); a1[e8] = row_dot(r1, wa);
                        if (e8 + 2 < 8) wvec_lds(wa, wp + (e8 + 2) * DM);
                        asm volatile("" ::: "memory"); WVEC_TOUCH(wb);
                        a0[e8 + 1] = row_dot(r0, wb); a1[e8 + 1] = row_dot(r1, wb); }
                    const float rbv = prb[cch * 8 + sub];
                    const float v0 = reduce_scatter8(a0, lane) + rbv, v1 = reduce_scatter8(a1, lane) + rbv;
#pragma unroll
                    for (int q = 0; q < 4; ++q) { lg[0][q] = (q == cch) ? v0 : lg[0][q]; lg[1][q] = (q == cch) ? v1 : lg[1][q]; }
                }
#pragma unroll
                for (int rr = 0; rr < 2; ++rr) {
                    float tv[4]; int te[4]; unsigned kk[4];
#pragma unroll
                    for (int cch = 0; cch < 4; ++cch) { const unsigned u = __float_as_uint(lg[rr][cch]); const unsigned o = (u & 0x80000000u) ? ~u : (u | 0x80000000u); kk[cch] = (o & ~31u) | (unsigned)(31 - (cch * 8 + sub)); }
#pragma unroll
                    for (int k = 0; k < 4; ++k) {
                        unsigned bk = max(max(kk[0], kk[1]), max(kk[2], kk[3]));
                        bk = max(bk, (unsigned)dpp_i<0x4E>((int)bk)); bk = max(bk, (unsigned)dpp_i<0x141>((int)bk)); bk = max(bk, (unsigned)dpp_i<0x140>((int)bk));
                        te[k] = 31 - (int)(bk & 31u); { const unsigned o = bk & ~31u; tv[k] = __uint_as_float((o & 0x80000000u) ? (o & 0x7fffffffu) : ~o); }
#pragma unroll
                        for (int cch = 0; cch < 4; ++cch) kk[cch] = (kk[cch] == bk) ? 0u : kk[cch];
                    }
                    const float e1 = fast_exp(tv[1] - tv[0]), e2 = fast_exp(tv[2] - tv[0]), e3 = fast_exp(tv[3] - tv[0]); const float inv = 1.0f / (1.0f + e1 + e2 + e3);
                    if (lane < 4) { const float gk = (lane == 0 ? 1.0f : (lane == 1 ? e1 : (lane == 2 ? e2 : e3))) * inv; const int ek = lane == 0 ? te[0] : (lane == 1 ? te[1] : (lane == 2 ? te[2] : te[3]));
                        L_E[(lr0 + rr) * 4 + lane] = ek; L_G[(lr0 + rr) * 4 + lane] = gk; }
                }
            };
            auto pr_load = [&](PR& f, int i) { const int row0 = bx * RPW + wave * RPV + i;
                if (l == 0) {
#pragma unroll
                    for (int j = 0; j < 4; ++j) { f.x0[j] = *(const u32x4*)(args.x + (size_t)row0 * DM + 256 * j + 4 * lane); f.x1[j] = *(const u32x4*)(args.x + (size_t)(row0 + 1) * DM + 256 * j + 4 * lane); }
                } else {
#pragma unroll
                    for (int j = 0; j < 4; ++j) { const u32x2 a = *(const u32x2*)((const bf16*)X + (size_t)row0 * DM + 256 * j + 4 * lane), b = *(const u32x2*)((const bf16*)X + (size_t)(row0 + 1) * DM + 256 * j + 4 * lane);
                        f.x0[j] = (u32x4){a.x, a.y, 0u, 0u}; f.x1[j] = (u32x4){b.x, b.y, 0u, 0u}; }
                }
#pragma unroll
                for (int j = 0; j < 4; ++j) { f.y0[j] = *(const u32x2*)(Yb + (size_t)row0 * DM + 256 * j + 4 * lane); f.y1[j] = *(const u32x2*)(Yb + (size_t)(row0 + 1) * DM + 256 * j + 4 * lane); } };
            auto pr_touch = [&](PR& f) { asm volatile("" :: "v"(f.x0[0]), "v"(f.x0[1]), "v"(f.x0[2]), "v"(f.x0[3]), "v"(f.x1[0]), "v"(f.x1[1]), "v"(f.x1[2]), "v"(f.x1[3]));
                asm volatile("" :: "v"(f.y0[0]), "v"(f.y0[1]), "v"(f.y0[2]), "v"(f.y0[3]), "v"(f.y1[0]), "v"(f.y1[1]), "v"(f.y1[2]), "v"(f.y1[3])); };
            PR A, B; PP pp; pr_load(A, 0);
#pragma nounroll
            for (int i = 0; i < RPV; i += 4) {
                pp_load(pp, i); asm volatile("" ::: "memory"); pr_touch(A); pr_load(B, i + 2); asm volatile("" ::: "memory"); pair_body(A, pp, i);
                pp_load(pp, i + 2); asm volatile("" ::: "memory"); pr_touch(B); pr_load(A, i + 4 < RPV ? i + 4 : RPV - 2); asm volatile("" ::: "memory"); pair_body(B, pp, i + 2);
            }
            pr_touch(A);
            __syncthreads();
            int my_e = 0, my_rank = 0;
            if (tid < RPW * 4) { my_e = L_E[tid]; my_rank = __hip_atomic_fetch_add(&L_CNT[my_e], 1, __ATOMIC_RELAXED, __HIP_MEMORY_SCOPE_WORKGROUP); }
            __syncthreads();
            if (tid < 32 && !dry) L_BASE[tid] = (int)__hip_atomic_fetch_add(ctl + CW_CUR + (l * 32 + tid) * 64, (unsigned)L_CNT[tid], __ATOMIC_RELAXED, __HIP_MEMORY_SCOPE_AGENT);
            __syncthreads();
            if (tid < RPW * 4 && !dry) { const int gi = bx * RPW * 4 + tid; const int slot = L_BASE[my_e] + my_rank; TOKE[gi] = my_e; TOKO[gi] = slot;
                ((int*)(ws + WS_RT))[(size_t)my_e * 32768 + slot] = gi >> 2; ((float*)(ws + WS_RT + 4 * MiB))[(size_t)my_e * 32768 + slot] = L_G[tid]; }
            __syncthreads();
        }
        SEAM(P + 7);

        if ((EN(8) || EN(9) || EN(10)) && (IN(P + 8) || IN(P + 9) || IN(P + 10))) {
            PH_BEGIN
            if (tid < 32) {
                const int cnt = (int)__hip_atomic_load(ctl + CW_CUR + (l * 32 + tid) * 64, RLX_AGENT); const int nt_ = (cnt + 255) >> 8;
                int incl = nt_;
#pragma unroll
                for (int o = 1; o < 32; o <<= 1) { const int t = __shfl_up(incl, o); if (tid >= o) incl += t; }
                const int first = incl - nt_;
                L_PSTART[tid] = first << 8; L_CNT[tid] = cnt;
#pragma nounroll
                for (int t = 0; t < nt_; ++t) L_TEXP[first + t] = (unsigned char)tid;
                if (tid == 31) MISC[16] = (unsigned)incl;
            }
            __syncthreads();
        }
        const int ntiles = (int)MISC[16];
        if (EN(9) && IN(P + 9)) {
            PH_BEGIN
            pg8::TileOrder S; S.init(ws + WS_H8, wl + WL_GU, ntiles, 8, DM / 2, G, bx, (size_t)2048 * DM, L_TEXP, L_PSTART, L_CNT, (const int*)(ws + WS_RT), true);
            EpiGU E{(unsigned char*)ACT, args.bgu + (size_t)l * NEXP * 2048}; S.noepi = args.qsel == 2;
            pg8::gemm_phase<EpiGU, true, true, true>(lds, DM / 2, S, E, tid);
        }
        SEAM(P + 9);
        if (EN(10) && IN(P + 10)) {
            PH_BEGIN
            pg8::TileOrder S; S.init(ACT, wl + WL_DN, ntiles, 4, DM / 2, G, bx, (size_t)DM * DM, L_TEXP, L_PSTART, L_CNT);
            EpiDN E{YR, args.bdn + (size_t)l * NEXP * DM, (const float*)(ws + WS_RT + 4 * MiB)};
            pg8::gemm_phase<EpiDN, true, false, true>(lds, DM / 2, S, E, tid);
        }
        SEAM(P + 10);

        if (EN(11) && IN(P + 11)) {
            PH_BEGIN
            if (tid < 32) { const int cnt = (int)__hip_atomic_load(ctl + CW_CUR + (l * 32 + tid) * 64, RLX_AGENT); const int nt_ = (cnt + 255) >> 8; int incl = nt_;
#pragma unroll
                for (int o = 1; o < 32; o <<= 1) { const int t = __shfl_up(incl, o); if (tid >= o) incl += t; }
                L_PSTART[tid] = (incl - nt_) << 8; }
            const bool more = (l + 1 < DEPTH);
            LAS float* wg = (LAS float*)lds; if (more) lds_fill(wg, WGc + (size_t)(l + 1) * NGATE * DM, NGATE * DM, tid);
            LAS float* pv = (LAS float*)(lds + 81920);
            { const int bq = (bx * (NT / G)) / SEQ; const float* modb = modl + (size_t)bq * 6 * DM; const float* mn = MOD + (size_t)(l + 1) * 8 * 6 * DM + (size_t)bq * 6 * DM;
              for (int i = tid * 4; i < (more ? 5 : 3) * DM; i += 512 * 4) { const int wv = i / DM, k = i % DM;
                  const float* src = wv == 0 ? modb + 5 * DM : (wv == 1 ? args.ln2g + (size_t)l * DM : (wv == 2 ? args.ln2b + (size_t)l * DM : (wv == 3 ? mn + DM : mn)));
                  *(LAS f32x4*)(pv + i) = *(const f32x4*)(src + k); } }
            __syncthreads();
            const bool dry = args.qsel != 0;
            float* dstf = dry ? (float*)ACT : args.out; bf16* dstb = dry ? (bf16*)ACT : (bf16*)X; bf16* Ho = dry ? (bf16*)((unsigned char*)ACT + 136 * MiB) : Hb; float* GLo = dry ? (float*)((unsigned char*)ACT + 208 * MiB) : GL; unsigned char* H8o = dry ? ((unsigned char*)ACT + 216 * MiB) : (ws + WS_H8);
            const int rpw = NT / NGW;
            int dest_l = 0; if (lane < rpw * 4) { const int gi = gw * rpw * 4 + lane; dest_l = L_PSTART[TOKE[gi]] + TOKO[gi]; }
            struct PF { u32x2 x[4]; unsigned y[4][4]; };
            auto pf_load = [&](PF& f, int i) { const int row = gw * rpw + i;
#pragma unroll
                for (int j = 0; j < 4; ++j) f.x[j] = *(const u32x2*)((const bf16*)X + (size_t)row * DM + 256 * j + 4 * lane);
#pragma unroll
                for (int k = 0; k < 4; ++k) { const unsigned char* yp = (const unsigned char*)YR + (size_t)__builtin_amdgcn_readlane(dest_l, 4 * i + k) * DM;
#pragma unroll
                    for (int j = 0; j < 4; ++j) f.y[k][j] = *(const unsigned*)(yp + 256 * j + 4 * lane); } };
            auto pf_touch = [&](PF& f) {
                asm volatile("" :: "v"(f.x[0]), "v"(f.x[1]), "v"(f.x[2]), "v"(f.x[3]));
#pragma unroll
                for (int k = 0; k < 4; ++k) asm volatile("" :: "v"(f.y[k][0]), "v"(f.y[k][1]), "v"(f.y[k][2]), "v"(f.y[k][3])); };
            auto pf_row = [&](PF& f, int i) {
                const int row = gw * rpw + i;
                Row r, y;
#pragma unroll
                for (int j = 0; j < 4; ++j) r.v[j] = (f32x4){bf_lo(f.x[j].x), bf_hi(f.x[j].x), bf_lo(f.x[j].y), bf_hi(f.x[j].y)};
#pragma unroll
                for (int j = 0; j < 4; ++j) y.v[j] = (f32x4){0.f, 0.f, 0.f, 0.f};
#pragma unroll
                for (int k = 0; k < 4; ++k)
#pragma unroll
                    for (int j = 0; j < 4; ++j) { const int w = (int)f.y[k][j]; const auto lo = __builtin_amdgcn_cvt_pk_f32_fp8(w, false), hi = __builtin_amdgcn_cvt_pk_f32_fp8(w, true); y.v[j] += (f32x4){lo[0], lo[1], hi[0], hi[1]}; }
#pragma unroll
                for (int j = 0; j < 4; ++j) { const f32x4 ga = *(const LAS f32x4*)(pv + 256 * j + 4 * lane) * (1.0f / S_Y); r.v[j] = r.v[j] * ALPHA + ga * y.v[j]; }
                row_ln(r); row_affine_l(r, pv + DM, pv + 2 * DM, 0.0f, lane); if (more) row_store_bf16(r, dstb + (size_t)row * DM, lane); else row_store(r, dstf + (size_t)row * DM, lane);
                if (more) { row_ln(r); row_affine_l(r, pv + 3 * DM, pv + 4 * DM, 1.0f, lane); ln1_tail(r, wg, Ho + (size_t)row * DM, H8o + (size_t)row * DM, GLo + (size_t)row * NGATE, lane); } };
            PF A, B; pf_load(A, 0);
#pragma nounroll
            for (int i = 0; i < rpw; i += 2) {
                pf_touch(A); pf_load(B, i + 1); pf_row(A, i);
                pf_touch(B); pf_load(A, i + 2 < rpw ? i + 2 : rpw - 1); pf_row(B, i + 1);
            }
            pf_touch(A);
            __syncthreads();
        }
        SEAM(P + 11);
    }
#undef IN
#undef SEAM
#undef PH_BEGIN
}

extern "C" void kernel_launch(void* const* d_in, const int* in_sizes, int n_in, void* d_out, int out_size, void* d_ws, size_t ws_size, hipStream_t stream) {
    static int grid = 0;
    if (grid == 0) {
        if (n_in != 26 || in_sizes[0] != NT * DM || out_size != NT * DM || ws_size < WS_END) { fprintf(stderr, "kernel_launch: unexpected shapes (n_in %d, in0 %d, out %d, ws %zu)\n", n_in, n_in > 0 ? in_sizes[0] : -1, out_size, ws_size); grid = -1; return; }
        int dev = 0, cus = 0, per_cu = 0;
        if (hipGetDevice(&dev) != hipSuccess || hipDeviceGetAttribute(&cus, hipDeviceAttributeMultiprocessorCount, dev) != hipSuccess) { grid = -1; return; }
        if (hipFuncSetAttribute((const void*)fwd, hipFuncAttributeMaxDynamicSharedMemorySize, LDS_BYTES) != hipSuccess) { fprintf(stderr, "kernel_launch: hipFuncSetAttribute failed\n"); grid = -1; return; }
        if (hipOccupancyMaxActiveBlocksPerMultiprocessor(&per_cu, (const void*)fwd, 512, LDS_BYTES) != hipSuccess || per_cu < 1) fprintf(stderr, "kernel_launch: occupancy query reports %d\n", per_cu);
        (void)hipGetLastError();
        if (cus < 256) { fprintf(stderr, "kernel_launch: %d CUs < 256: the persistent grid of 256 workgroups would not be resident\n", cus); grid = -1; return; }
        grid = 256;
    }
    if (grid < 0) return;
    if (hipMemsetAsync((char*)d_ws + WS_CTL, 0, CTL_BYTES, stream) != hipSuccess) return;
    Args a; memset(&a, 0, sizeof(a));
    a.x = (const float*)d_in[0]; a.c = (const float*)d_in[1]; a.pos = (const int*)d_in[2]; a.w_ada = (const float*)d_in[3]; a.b_ada = (const float*)d_in[4]; a.w_in = (const float*)d_in[5];
    a.w1k = (const float*)d_in[6]; a.w2k = (const float*)d_in[7]; a.pek = (const float*)d_in[8]; a.w1v = (const float*)d_in[9]; a.w2v = (const float*)d_in[10]; a.pev = (const float*)d_in[11];
    a.wba = (const float*)d_in[12]; a.wbb = (const float*)d_in[13]; a.wbc = (const float*)d_in[14]; a.wout = (const float*)d_in[15]; a.ln1g = (const float*)d_in[16]; a.ln1b = (const float*)d_in[17];
    a.rw = (const float*)d_in[18]; a.rb = (const float*)d_in[19]; a.wgu = (const float*)d_in[20]; a.bgu = (const float*)d_in[21]; a.wdn = (const float*)d_in[22]; a.bdn = (const float*)d_in[23];
    a.ln2g = (const float*)d_in[24]; a.ln2b = (const float*)d_in[25];
    a.out = (float*)d_out; a.ws = (unsigned char*)d_ws;
#if MK_ONE_LAUNCH
    a.ph_lo = 0; a.ph_hi = NPH; a.use_bar = 1; a.amask = 7;
    hipLaunchKernelGGL(fwd, dim3(grid), dim3(512), LDS_BYTES, stream, a);
#else
    a.use_bar = 0; a.amask = 7;
    for (int ph = 0; ph < NPH; ++ph) { a.ph_lo = ph; a.ph_hi = ph + 1; a.qsel = 0; hipLaunchKernelGGL(fwd, dim3(grid), dim3(512), LDS_BYTES, stream, a);
#if defined(PROBE_REP_A)
        if (ph == PROBE_REP_A) { a.qsel = PROBE_QSEL; a.amask = PROBE_AMASK; hipLaunchKernelGGL(fwd, dim3(grid), dim3(512), LDS_BYTES, stream, a); a.amask = 7; }
#endif
#if defined(PROBE_REP_B)
        if (ph == PROBE_REP_B) { a.qsel = 1; hipLaunchKernelGGL(fwd, dim3(grid), dim3(512), LDS_BYTES, stream, a); }
#endif
    }
#endif
    const hipError_t le = hipPeekAtLastError();
    if (le != hipSuccess) fprintf(stderr, "kernel_launch: launch failed: %s\n", hipGetErrorName(le));
}
```
